# Optimizing an MI355X kernel written in HIP

```python
import jax, jax.numpy as jnp
from jax import lax
import numpy as np

D_MODEL = 1024
BATCH = 16
SEQ = 2048
DEPTH = 1

CTX_LEN = 256
GRID_W = 64
ROWS_PER_CHUNK = 2
GMLP_CHUNK = ROWS_PER_CHUNK * GRID_W
MLSTM_CHUNK = 128
MLSTM_WIDTH = D_MODEL
N_HEADS = 4
HEAD_DIM = MLSTM_WIDTH // N_HEADS
N_GATES = 4 * N_HEADS
CONV_W = 3
GMLP_WIDTH = D_MODEL
GMLP_GROUP_DIM = 128
GMLP_GROUPS = GMLP_WIDTH // GMLP_GROUP_DIM
D_FF = 4 * D_MODEL
NEG = -1e30
EPS = 1e-6

OFF_Q = 0
OFF_K = OFF_Q + MLSTM_WIDTH
OFF_V = OFF_K + MLSTM_WIDTH
OFF_G = OFF_V + MLSTM_WIDTH
OFF_O = OFF_G + N_GATES
OFF_U = OFF_O + MLSTM_WIDTH
OFF_VG = OFF_U + GMLP_WIDTH
OFF_GA = OFF_VG + GMLP_WIDTH
OFF_GB = OFF_GA + D_MODEL
P_TOTAL = OFF_GB + D_MODEL

kernel_name = 'hybrid_mlstm_gmlp_dit_block'


def rmsnorm(x, g):
    xf = x.astype(jnp.float32)
    y = xf * lax.rsqrt(jnp.mean(xf * xf, axis=-1, keepdims=True) + EPS)
    return (y * g.astype(jnp.float32)).astype(x.dtype)


def modulate(xn, shift, scale):
    return xn * (1.0 + scale) + shift


def short_conv(x, w):
    pad = CONV_W // 2
    L = x.shape[1]
    xp = jnp.pad(x, ((0, 0), (pad, pad), (0, 0)))
    out = xp[:, 0:L] * w[0]
    for j in range(1, CONV_W):
        out = out + xp[:, j:j + L] * w[j]
    return out


def mlstm_inputs(p, conv_w, b_gate):
    B, L, _ = p.shape
    qk = jax.nn.silu(short_conv(p[..., OFF_Q:OFF_V], conv_w))
    q = qk[..., :MLSTM_WIDTH].reshape(B, L, N_HEADS, HEAD_DIM)
    k = (qk[..., MLSTM_WIDTH:] * (HEAD_DIM ** -0.5)).reshape(B, L, N_HEADS, HEAD_DIM)
    v = p[..., OFF_V:OFF_G].reshape(B, L, N_HEADS, HEAD_DIM)
    g = p[..., OFF_G:OFF_O].astype(jnp.float32) + b_gate.astype(jnp.float32)
    gi_f, gf_f, gi_b, gf_b = jnp.split(g, 4, axis=-1)
    fwd = (gi_f, jax.nn.log_sigmoid(gf_f))
    bwd = (gi_b, jax.nn.log_sigmoid(gf_b))
    return q, k, v, fwd, bwd


def init_state(B):
    C = jnp.zeros((B, N_HEADS, HEAD_DIM, HEAD_DIM), jnp.float32)
    n = jnp.zeros((B, N_HEADS, HEAD_DIM), jnp.float32)
    m = jnp.zeros((B, N_HEADS), jnp.float32)
    return (C, n, m)


def mlstm_chunked(q, k, v, log_i, log_f, state, return_h):
    B, L, H, d = q.shape
    nc = L // MLSTM_CHUNK

    def to_chunks(a):
        a = a.astype(jnp.float32).reshape((B, nc, MLSTM_CHUNK) + a.shape[2:])
        return jnp.moveaxis(a, (1, 3), (0, 2))

    xs = (to_chunks(q), to_chunks(k), to_chunks(v), to_chunks(log_i), to_chunks(log_f))
    tril = jnp.tril(jnp.ones((MLSTM_CHUNK, MLSTM_CHUNK), dtype=bool))

    def body(carry, inp):
        C, n, m = carry
        qc, kc, vc, li, lf = inp
        b = jnp.cumsum(lf, axis=-1)
        b_last = b[..., -1]
        w_end = b_last[..., None] - b + li
        m_new = jnp.maximum(b_last + m, jnp.max(w_end, axis=-1))
        e = jnp.exp(w_end - m_new[..., None])
        s_prev = jnp.exp(b_last + m - m_new)
        C_new = s_prev[..., None, None] * C + jnp.einsum('bhj,bhjd,bhjv->bhdv', e, kc, vc)
        n_new = s_prev[..., None] * n + jnp.einsum('bhj,bhjd->bhd', e, kc)
        if not return_h:
            return (C_new, n_new, m_new), None
        d_intra = jnp.where(tril, b[..., :, None] - b[..., None, :] + li[..., None, :], NEG)
        inter = b + m[..., None]
        m_i = jnp.maximum(inter, jnp.max(d_intra, axis=-1))
        w = jnp.exp(d_intra - m_i[..., None])
        s_inter = jnp.exp(inter - m_i)
        a = w * jnp.einsum('bhid,bhjd->bhij', qc, kc)
        num = jnp.einsum('bhij,bhjv->bhiv', a, vc) + s_inter[..., None] * jnp.einsum('bhid,bhdv->bhiv', qc, C)
        den = jnp.sum(a, axis=-1) + s_inter * jnp.einsum('bhid,bhd->bhi', qc, n)
        h = num / jnp.maximum(jnp.abs(den), jnp.exp(-m_i))[..., None]
        return (C_new, n_new, m_new), h

    state, hs = lax.scan(body, state, xs)
    if not return_h:
        return None, state
    h = jnp.moveaxis(hs, (0, 2), (1, 3)).reshape(B, L, H, d)
    return h, state


def bidir_mlstm(lat, ctx_in, need_ctx_h):
    qx, kx, vx, (lixf, lfxf), (lixb, lfxb) = lat
    qc, kc, vc, (licf, lfcf), (licb, lfcb) = ctx_in
    st0 = init_state(qx.shape[0])
    rev = lambda a: a[:, ::-1]
    hcf, st_f = mlstm_chunked(qc, kc, vc, licf, lfcf, st0, need_ctx_h)
    hxf, _ = mlstm_chunked(qx, kx, vx, lixf, lfxf, st_f, True)
    hcb, st_b = mlstm_chunked(rev(qc), rev(kc), rev(vc), rev(licb), rev(lfcb), st0, need_ctx_h)
    hxb, _ = mlstm_chunked(rev(qx), rev(kx), rev(vx), rev(lixb), rev(lfxb), st_b, True)
    hx = hxf + rev(hxb)
    hc = (hcf + rev(hcb)) if need_ctx_h else None
    return hx, hc


def spatial_gate(u, vg, g_sgu, w_s, b_s, n_chunks):
    B, L, _ = u.shape
    vn = rmsnorm(vg, g_sgu).reshape(B, n_chunks, GMLP_CHUNK, GMLP_GROUPS, GMLP_GROUP_DIM)
    s = jnp.einsum('gpq,bnqgc->bnpgc', w_s, vn) + jnp.transpose(b_s)[None, None, :, :, None]
    return u * s.reshape(B, L, GMLP_WIDTH)


def merge_branches(p, h_m, n_chunks, g_mh, w_a, w_s, b_s, g_sgu, w_b, w_out):
    B, L, _ = p.shape
    o = p[..., OFF_O:OFF_U]
    u = jax.nn.gelu(p[..., OFF_U:OFF_VG])
    vg = jax.nn.gelu(p[..., OFF_VG:OFF_GA])
    ga = p[..., OFF_GA:OFF_GB]
    gb = p[..., OFF_GB:P_TOTAL]
    hm = (jax.nn.sigmoid(o) * h_m.reshape(B, L, MLSTM_WIDTH).astype(p.dtype)).reshape(B, L, N_HEADS, HEAD_DIM)
    hm = rmsnorm(hm, g_mh.reshape(N_HEADS, HEAD_DIM)).reshape(B, L, MLSTM_WIDTH)
    ya = hm @ w_a
    yb = spatial_gate(u, vg, g_sgu, w_s, b_s, n_chunks) @ w_b
    y = jax.nn.sigmoid(ga) * ya + jax.nn.sigmoid(gb) * yb
    return y @ w_out


def sq_relu_mlp(xn, w1, w2):
    h = jax.nn.relu(xn @ w1)
    return (h * h) @ w2


def setup_inputs(seed: int = 0) -> dict:
    key = jax.random.key(seed)
    ks = jax.random.split(key, 24)
    f32 = jnp.float32
    nrm = lambda k, shape, scale: jax.random.normal(k, shape, f32) * scale
    i_bias = nrm(ks[10], (DEPTH, N_HEADS), 0.1)
    f_bias = 3.0 + 3.0 * jnp.linspace(0.0, 1.0, N_HEADS, dtype=f32)[None] + nrm(ks[11], (DEPTH, N_HEADS), 0.1)
    i_bias_b = nrm(ks[12], (DEPTH, N_HEADS), 0.1)
    f_bias_b = 3.0 + 3.0 * jnp.linspace(0.0, 1.0, N_HEADS, dtype=f32)[None] + nrm(ks[13], (DEPTH, N_HEADS), 0.1)
    return {
        'x': nrm(ks[0], (BATCH, SEQ, D_MODEL), 1.0),
        'c': nrm(ks[1], (BATCH, D_MODEL), 1.0),
        'ctx': nrm(ks[2], (BATCH, CTX_LEN, D_MODEL), 1.0),
        'c_ctx': nrm(ks[3], (D_MODEL,), 1.0),
        'norm1': 1.0 + nrm(ks[4], (DEPTH, D_MODEL), 0.05),
        'norm2': 1.0 + nrm(ks[5], (DEPTH, D_MODEL), 0.05),
        'w_mod': nrm(ks[6], (DEPTH, D_MODEL, 6 * D_MODEL), 0.5 * D_MODEL ** -0.5),
        'b_mod': nrm(ks[7], (DEPTH, 6 * D_MODEL), 0.02),
        'w_in': nrm(ks[8], (DEPTH, D_MODEL, P_TOTAL), D_MODEL ** -0.5),
        'conv_qk': nrm(ks[9], (DEPTH, CONV_W, 2 * MLSTM_WIDTH), CONV_W ** -0.5),
        'b_gate': jnp.concatenate([i_bias, f_bias, i_bias_b, f_bias_b], axis=-1),
        'g_mh': 1.0 + nrm(ks[14], (DEPTH, MLSTM_WIDTH), 0.05),
        'w_a': nrm(ks[15], (DEPTH, MLSTM_WIDTH, D_MODEL), MLSTM_WIDTH ** -0.5),
        'w_s': nrm(ks[16], (DEPTH, GMLP_GROUPS, GMLP_CHUNK, GMLP_CHUNK), GMLP_CHUNK ** -0.5),
        'b_s': 1.0 + nrm(ks[17], (DEPTH, GMLP_GROUPS, GMLP_CHUNK), 0.05),
        'g_sgu': 1.0 + nrm(ks[18], (DEPTH, GMLP_WIDTH), 0.05),
        'w_b': nrm(ks[19], (DEPTH, GMLP_WIDTH, D_MODEL), GMLP_WIDTH ** -0.5),
        'w_out': nrm(ks[20], (DEPTH, D_MODEL, D_MODEL), D_MODEL ** -0.5),
        'w1': nrm(ks[21], (DEPTH, D_MODEL, D_FF), D_MODEL ** -0.5),
        'w2': nrm(ks[22], (DEPTH, D_FF, D_MODEL), D_FF ** -0.5),
        'norm_f': 1.0 + nrm(ks[23], (D_MODEL,), 0.05),
    }


def reference(x, c, ctx, c_ctx, norm1, norm2, w_mod, b_mod, w_in, conv_qk, b_gate, g_mh,
              w_a, w_s, b_s, g_sgu, w_b, w_out, w1, w2, norm_f):
    B, S, D = x.shape
    rows = S // GRID_W
    n_lat_chunks = rows // ROWS_PER_CHUNK
    n_ctx_chunks = ctx.shape[1] // GMLP_CHUNK
    s_c = jax.nn.silu(c)
    s_cc = jax.nn.silu(c_ctx)
    for l in range(DEPTH):
        last = l == DEPTH - 1
        mod_x = s_c @ w_mod[l] + b_mod[l]
        sh1, sc1, g1, sh2, sc2, g2 = jnp.split(mod_x[:, None, :], 6, axis=-1)
        n_mod_c = 2 if last else 6
        mod_c = s_cc @ w_mod[l][:, :n_mod_c * D] + b_mod[l][:n_mod_c * D]
        mods_c = jnp.split(mod_c, n_mod_c, axis=-1)
        sh1c, sc1c = mods_c[0], mods_c[1]

        xn = modulate(rmsnorm(x, norm1[l]), sh1, sc1)
        cn = modulate(rmsnorm(ctx, norm1[l]), sh1c, sc1c)
        px = xn @ w_in[l]
        pc = cn @ (w_in[l][:, :OFF_O] if last else w_in[l])
        lat_in = mlstm_inputs(px, conv_qk[l], b_gate[l])
        ctx_in = mlstm_inputs(pc, conv_qk[l], b_gate[l])
        hx, hc = bidir_mlstm(lat_in, ctx_in, not last)
        mix_x = merge_branches(px, hx, n_lat_chunks, g_mh[l], w_a[l], w_s[l], b_s[l],
                               g_sgu[l], w_b[l], w_out[l])
        x = x + g1 * mix_x

        xn2 = modulate(rmsnorm(x, norm2[l]), sh2, sc2)
        x = x + g2 * sq_relu_mlp(xn2, w1[l], w2[l])

        if not last:
            g1c, sh2c, sc2c, g2c = mods_c[2], mods_c[3], mods_c[4], mods_c[5]
            mix_c = merge_branches(pc, hc, n_ctx_chunks, g_mh[l], w_a[l], w_s[l], b_s[l],
                                   g_sgu[l], w_b[l], w_out[l])
            ctx = ctx + g1c * mix_c
            cn2 = modulate(rmsnorm(ctx, norm2[l]), sh2c, sc2c)
            ctx = ctx + g2c * sq_relu_mlp(cn2, w1[l], w2[l])
    return rmsnorm(x, norm_f)
```

```cpp
#include <hip/hip_runtime.h>
#include <cstdio>
#include <cstdint>
namespace pg8 {
#define PG8_LAS __attribute__((address_space(3)))
typedef unsigned short bf16_t;
typedef short bf16x8 __attribute__((ext_vector_type(8)));
typedef float f32x4 __attribute__((ext_vector_type(4)));
typedef unsigned u32x4 __attribute__((ext_vector_type(4)));
constexpr int BM = 256, BK = 64, HALF = 128, HTB = HALF * BK * 2  , STAGE_BYTES = 8 * HTB, NXCD = 8, WGM = 8;

__host__ __device__ __forceinline__ int lds_byte(int r, int c) { const int st = (r >> 4) * 2 + (c >> 5), rr = r & 15, cc = c & 31, ob = rr * 64 + cc * 2; return st * 1024 + (ob ^ (((ob >> 9) & 1) << 5)); }
__host__ __device__ __forceinline__ void stage_rc(int b, int& R, int& C) { const int st = b / 1024, sb = b % 1024, swz = sb ^ (((sb >> 9) & 1) << 5); R = (st >> 1) * 16 + swz / 64; C = (st & 1) * 32 + (swz % 64) / 2; }
__host__ __device__ __forceinline__ int perm32(int rho) { const int n = rho >> 4, i = rho & 15; return 8 * (i >> 2) + 4 * n + (i & 3); }

struct Unit { int pm, pn; };
struct Gemm { const bf16_t* A; const bf16_t* Bt; int M, N, K; };

struct StaticOrder {
    int nM, nN, nwg, G, c;
    __host__ __device__ void init(int M, int N, int G_, int c_) { nM = M / BM; nN = N / BM; nwg = nM * nN; G = G_; c = c_; }
    __host__ __device__ bool next(int i, Unit& u) const {
        const long L = (long)i * G + c; if (L >= nwg) return false;
        int wgid = (int)L; { const int q = nwg / NXCD, r = nwg % NXCD, xcd = wgid % NXCD, off = wgid / NXCD; wgid = (xcd < r ? xcd * (q + 1) : r * (q + 1) + (xcd - r) * q) + off; }
        const int nig = WGM * nN, gid = wgid / nig, fm = gid * WGM, gsz = (nM - fm) < WGM ? (nM - fm) : WGM;
        u.pm = fm + ((wgid % nig) % gsz); u.pn = (wgid % nig) / gsz; return true;
    }
    __device__ __forceinline__ void a_ready(const Unit&) const {}
    __device__ __forceinline__ void done(const Unit&) const {}
};
__device__ __forceinline__ unsigned cvt_pk_bf16(float lo, float hi) { unsigned r; asm volatile("v_cvt_pk_bf16_f32 %0, %1, %2" : "=v"(r) : "v"(lo), "v"(hi)); return r; }
typedef float f32x2 __attribute__((ext_vector_type(2)));
template <class Epi, class Sched, bool ALIGN_EPI = false, bool SP2 = false>
__device__ __forceinline__ void gemm_phase(PG8_LAS unsigned char* lds, const Gemm g, const Sched& S, const Epi& E) {
    int tid_ = threadIdx.x; asm volatile("" : "+v"(tid_));
    const int tid = tid_, wid = __builtin_amdgcn_readfirstlane(tid >> 6), lane = tid & 63, wr = wid >> 2, wc = wid & 3, fr = lane & 15, fq = lane >> 4;
    const int K = g.K, nt = K / BK;
    unsigned voffA[2], voffB[2];
#pragma unroll
    for (int i = 0; i < 2; ++i) { int R, C; stage_rc(tid * 16 + i * 8192, R, C); const int Rb = Epi::PERM ? ((R & ~31) + perm32(R & 31)) : R;
        voffA[i] = (unsigned)(R * K + C) * 2u; voffB[i] = (unsigned)(Rb * K + C) * 2u; }
    const size_t kstep = (size_t)(BK * 2);
    const size_t hstep = (size_t)HALF * K * 2;
    const size_t tstep = 2 * hstep;
    const unsigned ldsw = (unsigned)wid * 1024u;
    const int aoff = lds_byte(wr * 64 + fr, fq * 8), boff = lds_byte(wc * 32 + fr, fq * 8);
#define PG8_SA(b, h) (((b) * 2 + (h)) * HTB)
#define PG8_SB(b, h) ((4 + (b) * 2 + (h)) * HTB)
#define PG8_STAGE(bufoff, gbase, voff) do { _Pragma("unroll") for (int _i = 0; _i < 2; ++_i) \
        __builtin_amdgcn_global_load_lds((const unsigned*)((const char*)(gbase) + (voff)[_i]), (PG8_LAS unsigned*)(lds + (bufoff) + ldsw + _i * 8192), 16, 0, 0); } while (0)
#define PG8_LDA(dst, b, h) do { _Pragma("unroll") for (int m = 0; m < 4; ++m) _Pragma("unroll") for (int k = 0; k < 2; ++k) dst[m][k] = *(const PG8_LAS bf16x8*)(lds + PG8_SA(b, h) + aoff + m * 2048 + k * 1024); } while (0)
#define PG8_LDB(dst, b, h) do { _Pragma("unroll") for (int n = 0; n < 2; ++n) _Pragma("unroll") for (int k = 0; k < 2; ++k) dst[n][k] = *(const PG8_LAS bf16x8*)(lds + PG8_SB(b, h) + boff + n * 2048 + k * 1024); } while (0)
#define PG8_MMA(ai, bj, At, Bt) do { __builtin_amdgcn_s_setprio(1); _Pragma("unroll") for (int m = 0; m < 4; ++m) _Pragma("unroll") for (int n = 0; n < 2; ++n) _Pragma("unroll") for (int k = 0; k < 2; ++k) \
        acc[ai][bj][m][n] = __builtin_amdgcn_mfma_f32_16x16x32_bf16(Bt[n][k], At[m][k], acc[ai][bj][m][n], 0, 0, 0); __builtin_amdgcn_s_setprio(0); } while (0)
#define PG8_WAIT_V(n) asm volatile("s_waitcnt vmcnt(" #n ")" ::: "memory")
#define PG8_WAIT_L(n) asm volatile("s_waitcnt lgkmcnt(" #n ")" ::: "memory")
#define PG8_BAR __builtin_amdgcn_s_barrier()
#define PG8_SCHED __builtin_amdgcn_sched_barrier(0)
    Unit cur, nxt; int ui = 0;
    if (!S.next(0, cur)) return;
    f32x4 acc[2][2][4][2];
#pragma unroll
    for (int a = 0; a < 2; ++a)
#pragma unroll
        for (int b = 0; b < 2; ++b)
#pragma unroll
            for (int m = 0; m < 4; ++m)
#pragma unroll
                for (int n = 0; n < 2; ++n) acc[a][b][m][n] = (f32x4){0.f, 0.f, 0.f, 0.f};
    bf16x8 At[4][2], B0[2][2], B1[2][2];
    const char* cA = (const char*)g.A + (size_t)cur.pm * tstep; const char* cB = (const char*)g.Bt + (size_t)cur.pn * tstep;
    S.a_ready(cur);
    if constexpr (SP2) {
        PG8_STAGE(PG8_SB(0, 0), cB, voffB); PG8_STAGE(PG8_SB(0, 1), cB + hstep, voffB); PG8_STAGE(PG8_SA(0, 0), cA, voffA); PG8_STAGE(PG8_SA(0, 1), cA + hstep, voffA);
        if (wr == 1) PG8_BAR;
        PG8_WAIT_V(2); PG8_BAR;
        PG8_STAGE(PG8_SB(1, 0), cB + kstep, voffB); PG8_STAGE(PG8_SA(1, 0), cA + kstep, voffA); PG8_STAGE(PG8_SB(1, 1), cB + hstep + kstep, voffB);
        PG8_WAIT_V(6); PG8_BAR;
    } else {
        PG8_STAGE(PG8_SB(0, 0), cB, voffB); PG8_STAGE(PG8_SA(0, 0), cA, voffA); PG8_STAGE(PG8_SB(0, 1), cB + hstep, voffB); PG8_STAGE(PG8_SA(0, 1), cA + hstep, voffA);
        if (wr == 1) PG8_BAR;
        PG8_WAIT_V(4); PG8_BAR;
        PG8_STAGE(PG8_SB(1, 0), cB + kstep, voffB); PG8_STAGE(PG8_SA(1, 0), cA + kstep, voffA); PG8_STAGE(PG8_SB(1, 1), cB + hstep + kstep, voffB);
        PG8_WAIT_V(6); PG8_BAR;
    }
    for (;;) {
        const bool has_next = S.next(ui + 1, nxt);
        const char* nA = has_next ? (const char*)g.A + (size_t)nxt.pm * tstep : cA; const char* nB = has_next ? (const char*)g.Bt + (size_t)nxt.pn * tstep : cB;
        for (int t = 0; t < nt; t += 2) {
            const bool last = (t == nt - 2);
            const char* a1 = cA + (size_t)(t + 1) * kstep;
            const char* a2 = last ? nA : cA + (size_t)(t + 2) * kstep; const char* b2 = last ? nB : cB + (size_t)(t + 2) * kstep;
            const char* a3 = a2 + kstep; const char* b3 = b2 + kstep;
            if (last && has_next) S.a_ready(nxt);
            if constexpr (SP2) {
            PG8_LDB(B0, 0, 0); PG8_LDB(B1, 0, 1); PG8_SCHED; PG8_LDA(At, 0, 0); PG8_STAGE(PG8_SA(1, 1), a1 + hstep, voffA);
            PG8_WAIT_V(8); PG8_WAIT_L(0); PG8_BAR; PG8_MMA(0, 0, At, B0); PG8_MMA(0, 1, At, B1); PG8_BAR; PG8_SCHED;
            PG8_LDA(At, 0, 1); PG8_STAGE(PG8_SB(0, 0), b2, voffB); PG8_STAGE(PG8_SB(0, 1), b2 + hstep, voffB); PG8_STAGE(PG8_SA(0, 0), a2, voffA);
            PG8_WAIT_V(8); PG8_WAIT_L(0); PG8_BAR; PG8_MMA(1, 0, At, B0); PG8_MMA(1, 1, At, B1); PG8_BAR; PG8_SCHED;
            PG8_LDB(B0, 1, 0); PG8_LDB(B1, 1, 1); PG8_SCHED; PG8_LDA(At, 1, 0); PG8_STAGE(PG8_SA(0, 1), a2 + hstep, voffA);
            PG8_WAIT_V(8); PG8_WAIT_L(0); PG8_BAR; PG8_MMA(0, 0, At, B0); PG8_MMA(0, 1, At, B1); PG8_BAR; PG8_SCHED;
            PG8_LDA(At, 1, 1); PG8_STAGE(PG8_SB(1, 0), b3, voffB); PG8_STAGE(PG8_SB(1, 1), b3 + hstep, voffB); PG8_STAGE(PG8_SA(1, 0), a3, voffA);
            PG8_WAIT_V(8); PG8_WAIT_L(0); PG8_BAR; PG8_MMA(1, 0, At, B0); PG8_MMA(1, 1, At, B1); PG8_BAR; PG8_SCHED;
            } else {
            PG8_LDB(B0, 0, 0); PG8_SCHED; PG8_LDA(At, 0, 0); PG8_STAGE(PG8_SA(1, 1), a1 + hstep, voffA);
            PG8_WAIT_L(8); PG8_BAR; PG8_WAIT_L(0); PG8_MMA(0, 0, At, B0); PG8_BAR; PG8_SCHED;
            PG8_LDB(B1, 0, 1); PG8_STAGE(PG8_SB(0, 0), b2, voffB);
            PG8_BAR; PG8_WAIT_L(0); PG8_MMA(0, 1, At, B1); PG8_BAR;
            PG8_LDA(At, 0, 1); PG8_STAGE(PG8_SA(0, 0), a2, voffA);
            PG8_BAR; PG8_WAIT_L(0); PG8_MMA(1, 0, At, B0); PG8_BAR; PG8_SCHED;
            PG8_STAGE(PG8_SB(0, 1), b2 + hstep, voffB);
            PG8_WAIT_V(6); PG8_BAR; PG8_MMA(1, 1, At, B1); PG8_BAR;
            PG8_LDB(B0, 1, 0); PG8_SCHED; PG8_LDA(At, 1, 0); PG8_STAGE(PG8_SA(0, 1), a2 + hstep, voffA);
            PG8_WAIT_L(8); PG8_BAR; PG8_WAIT_L(0); PG8_MMA(0, 0, At, B0); PG8_BAR; PG8_SCHED;
            PG8_LDB(B1, 1, 1); PG8_STAGE(PG8_SB(1, 0), b3, voffB);
            PG8_BAR; PG8_WAIT_L(0); PG8_MMA(0, 1, At, B1); PG8_BAR;
            PG8_LDA(At, 1, 1); PG8_STAGE(PG8_SA(1, 0), a3, voffA);
            PG8_BAR; PG8_WAIT_L(0); PG8_MMA(1, 0, At, B0); PG8_BAR; PG8_SCHED;
            PG8_STAGE(PG8_SB(1, 1), b3 + hstep, voffB);
            PG8_WAIT_V(6); PG8_BAR; PG8_MMA(1, 1, At, B1); PG8_BAR;
            }
        }
        if constexpr (ALIGN_EPI) { if (wr == 0) PG8_BAR; }
        if constexpr (!Epi::AFTER_DRAIN) { E(acc, cur, wr, wc, fr, fq); S.done(cur); }
        if (!has_next) break;
#pragma unroll
        for (int a = 0; a < 2; ++a)
#pragma unroll
            for (int b = 0; b < 2; ++b)
#pragma unroll
                for (int m = 0; m < 4; ++m)
#pragma unroll
                    for (int n = 0; n < 2; ++n) acc[a][b][m][n] = (f32x4){0.f, 0.f, 0.f, 0.f};
        cur = nxt; cA = nA; cB = nB; ++ui;
        if constexpr (ALIGN_EPI) { if (wr == 1) PG8_BAR; }
    }
    PG8_WAIT_V(0);
    if constexpr (!ALIGN_EPI) { if (wr == 0) PG8_BAR; }
    PG8_BAR;
    if constexpr (Epi::AFTER_DRAIN) { E.fused(acc, cur, wr, wc, fr, fq, lds, wid, lane); S.done(cur); }
#undef PG8_SA
#undef PG8_SB
#undef PG8_STAGE
#undef PG8_LDA
#undef PG8_LDB
#undef PG8_MMA
#undef PG8_WAIT_V
#undef PG8_WAIT_L
#undef PG8_BAR
#undef PG8_SCHED
}
}
#ifndef MK_N_LAUNCHES
#define MK_N_LAUNCHES 1
#endif
constexpr int NWAVES = 8;
constexpr int DM = 1024, BATCH = 16, SEQ = 2048, CTXL = 256, NHEAD = 4, HD = 256, FF = 4096, PT = 8208;
constexpr int NGRP = 2, GBAT = BATCH / NGRP;
constexpr int RL = GBAT * SEQ, RC = GBAT * CTXL, RT = RL + RC;
constexpr float EPS = 1e-6f;
constexpr int NPG = 11;
constexpr int NPHASE = 1 + NGRP * NPG;

constexpr size_t MiB = 1u << 20;
constexpr size_t WS_CTL = 0, CTL_ZERO_BYTES = 1 * MiB;
constexpr size_t WS_MODX = 1 * MiB, WS_MODC = 1 * MiB + 512 * 1024;
constexpr size_t WS_WIN = 2 * MiB, WS_WA = 18 * MiB, WS_WB = 20 * MiB, WS_WOUT = 22 * MiB, WS_W1 = 24 * MiB, WS_W2 = 32 * MiB;
constexpr size_t WS_GATES = 40 * MiB;
constexpr size_t WS_XN = 42 * MiB;
constexpr size_t WS_Q = 78 * MiB, WS_K = 114 * MiB, WS_V = 150 * MiB;
constexpr size_t WS_O = 186 * MiB, WS_U = 218 * MiB, WS_VG = 250 * MiB, WS_GA = 282 * MiB, WS_GB = 314 * MiB;
constexpr size_t WS_QP = 346 * MiB, WS_KP = 382 * MiB, WS_HB = 418 * MiB;
constexpr size_t WS_H1 = 78 * MiB;
constexpr size_t WS_END = 482 * MiB;
constexpr int CW_BAR = 4096;

constexpr int RING_BYTES = 131072;
constexpr int LDSCTL_OFF = RING_BYTES, MISC_OFF = LDSCTL_OFF + 320;
constexpr int LDS_BYTES = 147456;

#define LAS __attribute__((address_space(3)))
typedef unsigned short bf16;
typedef unsigned v4u __attribute__((ext_vector_type(4)));
typedef unsigned v2u __attribute__((ext_vector_type(2)));
typedef float f32x4 __attribute__((ext_vector_type(4)));
#define LDS_WAIT() asm volatile("s_waitcnt lgkmcnt(0)" ::: "memory")
#define VM_WAIT() asm volatile("s_waitcnt vmcnt(0)" ::: "memory")
__device__ __forceinline__ unsigned f2bf(float f) { unsigned u = __builtin_bit_cast(unsigned, f); return (u + 0x7fffu + ((u >> 16) & 1u)) >> 16; }
__device__ __forceinline__ unsigned pk2(float lo, float hi) { return f2bf(lo) | (f2bf(hi) << 16); }
__device__ __forceinline__ float bflo(unsigned w) { return __builtin_bit_cast(float, w << 16); }
__device__ __forceinline__ float bfhi(unsigned w) { return __builtin_bit_cast(float, w & 0xffff0000u); }
__device__ __forceinline__ float bf2f(bf16 b) { return __builtin_bit_cast(float, ((unsigned)b) << 16); }
__device__ __forceinline__ float wave_sum(float v) {
#pragma unroll
    for (int o = 1; o < 64; o <<= 1) v += __shfl_xor(v, o);
    return v;
}
__device__ __forceinline__ float fexp(float x) { return __builtin_amdgcn_exp2f(x * 1.4426950408889634f); }
__device__ __forceinline__ float sigmoidf_(float x) { return __builtin_amdgcn_rcpf(1.f + fexp(-x)); }
__device__ __forceinline__ float siluf_(float x) { return x * __builtin_amdgcn_rcpf(1.f + fexp(-x)); }
__device__ __forceinline__ float gelu_tanh(float x) {
    const float z2 = 1.5957691216057308f * (x + 0.044715f * x * x * x);
    return x * __builtin_amdgcn_rcpf(1.f + fexp(-z2));
}
__device__ __forceinline__ float logsigmoidf_(float x) { return fminf(x, 0.f) - log1pf(expf(-fabsf(x))); }

#define XB_TMO      128
#define XB_XCNT(j)  (256  + 64 * (j))
#define XB_XSUB(j)  (1280 + 64 * (j))
#define XB_XGEN(j)  (2304 + 64 * (j))
#define XB_TOP      3328
#define XB_TOPGEN   3392
#define XCD_BAR_WORDS 3456
#define XB_SPIN_CAP (1u << 18)

__device__ __forceinline__ unsigned xb_ld(unsigned* p)              { return __hip_atomic_load(p, __ATOMIC_RELAXED, __HIP_MEMORY_SCOPE_AGENT); }
__device__ __forceinline__ unsigned xb_add(unsigned* p, unsigned v) { return __hip_atomic_fetch_add(p, v, __ATOMIC_RELAXED, __HIP_MEMORY_SCOPE_AGENT); }
__device__ __forceinline__ unsigned xb_xcc_id() { return (unsigned)__builtin_amdgcn_s_getreg((3 << 11) | 20) & 0xFu; }
#define XB_SPIN(cond, bar) do { unsigned _sp = 0; while (cond) { __builtin_amdgcn_s_sleep(1); \
    if ((++_sp & 255u) == 0u) { if (xb_ld(&(bar)[XB_TMO])) break; if (_sp > XB_SPIN_CAP) { atomicAdd(&(bar)[XB_TMO], 1u); break; } } } } while (0)

struct XcdBarrier {
    unsigned* bar; unsigned x;
    volatile LAS unsigned* st;
};

__device__ __forceinline__ XcdBarrier xcd_barrier_post(unsigned* bar, volatile LAS unsigned* st) {
    XcdBarrier b; b.bar = bar; b.x = xb_xcc_id(); b.st = st;
    if (threadIdx.x == 0) (void)xb_add(&bar[XB_XCNT(b.x)], 1u);
    return b;
}
__device__ __forceinline__ void xcd_barrier_complete(unsigned* bar, unsigned x, unsigned& nloc, unsigned& nx) {
    const unsigned G = gridDim.x * gridDim.y * gridDim.z;
    unsigned sum, cnt, mine, sp = 0u;
    for (;;) {
        sum = 0u; cnt = 0u; mine = 0u;
#pragma unroll
        for (unsigned j = 0; j < 16; ++j) { const unsigned c = xb_ld(&bar[XB_XCNT(j)]); sum += c; cnt += (c > 0u) ? 1u : 0u; mine = (j == x) ? c : mine; }
        if (sum == G) break;
        __builtin_amdgcn_s_sleep(1);
        if ((++sp & 255u) == 0u) { if (xb_ld(&bar[XB_TMO])) break; if (sp > XB_SPIN_CAP) { atomicAdd(&bar[XB_TMO], 1u); break; } }
    }
    nloc = mine > 0u ? mine : 1u; nx = cnt > 0u ? cnt : 1u;
}

__device__ __forceinline__ void xcd_barrier(const XcdBarrier& b) {
    asm volatile("s_waitcnt vmcnt(0)" ::: "memory");
    __syncthreads();
    if (threadIdx.x == 0) {
        unsigned* bar = b.bar;
        __builtin_amdgcn_s_waitcnt(0);
        unsigned nloc = b.st[0], nx = b.st[1];
        if (nloc == 0u) { xcd_barrier_complete(bar, b.x, nloc, nx); b.st[0] = nloc; b.st[1] = nx; }
        const unsigned old = xb_add(&bar[XB_XSUB(b.x)], 1u);
        const unsigned gen = old / nloc;
        if (old + 1u == (gen + 1u) * nloc) {
            __builtin_amdgcn_fence(__ATOMIC_RELEASE, "agent");
            asm volatile("s_waitcnt vmcnt(0)" ::: "memory");
            const unsigned og = xb_add(&bar[XB_TOP], 1u);
            const unsigned tg = og / nx;
            if (og + 1u == (tg + 1u) * nx) xb_add(&bar[XB_TOPGEN], 1u);
            else XB_SPIN(xb_ld(&bar[XB_TOPGEN]) == tg, bar);
            __builtin_amdgcn_fence(__ATOMIC_ACQUIRE, "agent");
            xb_add(&bar[XB_XGEN(b.x)], 1u);
            asm volatile("s_waitcnt vmcnt(0)" ::: "memory");
        } else {
            XB_SPIN(xb_ld(&bar[XB_XGEN(b.x)]) == gen, bar);
            __builtin_amdgcn_fence(__ATOMIC_ACQUIRE, "agent");
            asm volatile("s_waitcnt vmcnt(0)" ::: "memory");
        }
    }
    __syncthreads();
}
struct Args { const float* in[21]; float* out; unsigned char* ws; int ph_lo, ph_hi; };
enum { I_X = 0, I_C, I_CTX, I_CCTX, I_NORM1, I_NORM2, I_WMOD, I_BMOD, I_WIN, I_CONV, I_BGATE, I_GMH, I_WA, I_WS, I_BS, I_GSGU, I_WB, I_WOUT, I_W1, I_W2, I_NORMF };

struct Gemm1Order {
    pg8::StaticOrder so; int G, c;
    __device__ void init(int G_, int c_) { G = G_; c = c_; so.init(RL, 8192, G_, c_); }
    __device__ bool next(int i, pg8::Unit& u) const {
        const int L = i * G + c;
        if (L < 2048) return so.next(i, u);
        const int r = L - 2048; if (r >= 96) return false;
        u.pm = 64 + r / 12; u.pn = r % 12; return true;
    }
    __device__ __forceinline__ void a_ready(const pg8::Unit&) const {}
    __device__ __forceinline__ void done(const pg8::Unit&) const {}
};

struct EpiPx {
    static constexpr bool PERM = true, AFTER_DRAIN = false;
    unsigned char* ws;
    __device__ __forceinline__ void operator()(const pg8::f32x4 (&acc)[2][2][4][2], const pg8::Unit& u, int wr, int wc, int fr, int fq) const {
        asm volatile("" : "+v"(fr), "+v"(fq));
        const int gidx = u.pn >> 2;
        bf16* base = (bf16*)(ws + (gidx < 3 ? WS_Q + (size_t)gidx * 36 * MiB : WS_O + (size_t)(gidx - 3) * 32 * MiB));
        const bool act = (gidx == 4) || (gidx == 5);
        const int row0 = u.pm * 256 + wr * 64 + fr, col0 = (u.pn & 3) * 256 + wc * 32 + 8 * fq;
#pragma unroll
        for (int ai = 0; ai < 2; ++ai)
#pragma unroll
            for (int m = 0; m < 4; ++m) { bf16* rowp = base + (size_t)(row0 + ai * 128 + m * 16) * DM + col0;
#pragma unroll
                for (int bj = 0; bj < 2; ++bj) { pg8::f32x4 v0 = acc[ai][bj][m][0], v1 = acc[ai][bj][m][1];
                    if (act) {
#pragma unroll
                        for (int j = 0; j < 4; ++j) { v0[j] = gelu_tanh(v0[j]); v1[j] = gelu_tanh(v1[j]); } }
                    v4u w; w.x = pg8::cvt_pk_bf16(v0[0], v0[1]); w.y = pg8::cvt_pk_bf16(v0[2], v0[3]); w.z = pg8::cvt_pk_bf16(v1[0], v1[1]); w.w = pg8::cvt_pk_bf16(v1[2], v1[3]);
                    *(v4u*)(rowp + bj * 128) = w; }
                asm volatile("" ::: "memory"); }
    }
};
template <int MODE> struct EpiGate {
    static constexpr bool PERM = true, AFTER_DRAIN = false;
    const bf16* Gt; bf16* T;
    __device__ __forceinline__ void operator()(const pg8::f32x4 (&acc)[2][2][4][2], const pg8::Unit& u, int wr, int wc, int fr, int fq) const {
        asm volatile("" : "+v"(fr), "+v"(fq));
        const int row0 = u.pm * 256 + wr * 64 + fr, col0 = u.pn * 256 + wc * 32 + 8 * fq;
#pragma unroll
        for (int ai = 0; ai < 2; ++ai)
#pragma unroll
            for (int m = 0; m < 4; ++m) { const size_t off = (size_t)(row0 + ai * 128 + m * 16) * DM + col0;
#pragma unroll
                for (int bj = 0; bj < 2; ++bj) {
                    const v4u gw = *(const v4u*)(Gt + off + bj * 128);
                    float gv[8] = {bflo(gw.x), bfhi(gw.x), bflo(gw.y), bfhi(gw.y), bflo(gw.z), bfhi(gw.z), bflo(gw.w), bfhi(gw.w)};
                    float tv[8] = {0.f, 0.f, 0.f, 0.f, 0.f, 0.f, 0.f, 0.f};
                    if (MODE == 1) { const v4u tw = *(const v4u*)(T + off + bj * 128);
                        tv[0] = bflo(tw.x); tv[1] = bfhi(tw.x); tv[2] = bflo(tw.y); tv[3] = bfhi(tw.y); tv[4] = bflo(tw.z); tv[5] = bfhi(tw.z); tv[6] = bflo(tw.w); tv[7] = bfhi(tw.w); }
                    float r[8];
#pragma unroll
                    for (int j = 0; j < 4; ++j) { r[j] = tv[j] + sigmoidf_(gv[j]) * acc[ai][bj][m][0][j]; r[4 + j] = tv[4 + j] + sigmoidf_(gv[4 + j]) * acc[ai][bj][m][1][j]; }
                    v4u w; w.x = pg8::cvt_pk_bf16(r[0], r[1]); w.y = pg8::cvt_pk_bf16(r[2], r[3]); w.z = pg8::cvt_pk_bf16(r[4], r[5]); w.w = pg8::cvt_pk_bf16(r[6], r[7]);
                    *(v4u*)(T + off + bj * 128) = w; }
                asm volatile("" ::: "memory"); }
    }
};
struct EpiRes {
    static constexpr bool PERM = false, AFTER_DRAIN = false;
    const float* resid; float* out; const float* modx; int goff; int grow0;
    __device__ __forceinline__ void operator()(const pg8::f32x4 (&acc)[2][2][4][2], const pg8::Unit& u, int wr, int wc, int fr, int fq) const {
        asm volatile("" : "+v"(fr), "+v"(fq));
        const int growt = grow0 + u.pm * 256, b = growt >> 11;
        const int row0 = growt + wr * 64 + fr, col0 = u.pn * 256 + wc * 32 + 4 * fq;
        const float* gp = modx + (size_t)b * 6144 + goff + col0;
        pg8::f32x4 gv[2][2];
#pragma unroll
        for (int bj = 0; bj < 2; ++bj)
#pragma unroll
            for (int n = 0; n < 2; ++n) gv[bj][n] = *(const pg8::f32x4*)(gp + bj * 128 + n * 16);
#pragma unroll
        for (int ai = 0; ai < 2; ++ai)
#pragma unroll
            for (int m = 0; m < 4; ++m) { const size_t off = (size_t)(row0 + ai * 128 + m * 16) * DM + col0;
#pragma unroll
                for (int bj = 0; bj < 2; ++bj)
#pragma unroll
                    for (int n = 0; n < 2; ++n) { const pg8::f32x4 rv = *(const pg8::f32x4*)(resid + off + bj * 128 + n * 16);
                        *(pg8::f32x4*)(out + off + bj * 128 + n * 16) = rv + gv[bj][n] * acc[ai][bj][m][n]; }
                asm volatile("" ::: "memory"); }
    }
};
struct EpiRelu2 {
    static constexpr bool PERM = true, AFTER_DRAIN = false;
    bf16* O;
    __device__ __forceinline__ void operator()(const pg8::f32x4 (&acc)[2][2][4][2], const pg8::Unit& u, int wr, int wc, int fr, int fq) const {
        asm volatile("" : "+v"(fr), "+v"(fq));
        const int row0 = u.pm * 256 + wr * 64 + fr, col0 = u.pn * 256 + wc * 32 + 8 * fq;
#pragma unroll
        for (int ai = 0; ai < 2; ++ai)
#pragma unroll
            for (int m = 0; m < 4; ++m) { bf16* rowp = O + (size_t)(row0 + ai * 128 + m * 16) * FF + col0;
#pragma unroll
                for (int bj = 0; bj < 2; ++bj) { pg8::f32x4 v0 = acc[ai][bj][m][0], v1 = acc[ai][bj][m][1];
#pragma unroll
                    for (int j = 0; j < 4; ++j) { const float a0 = fmaxf(v0[j], 0.f), a1 = fmaxf(v1[j], 0.f); v0[j] = a0 * a0; v1[j] = a1 * a1; }
                    v4u w; w.x = pg8::cvt_pk_bf16(v0[0], v0[1]); w.y = pg8::cvt_pk_bf16(v0[2], v0[3]); w.z = pg8::cvt_pk_bf16(v1[0], v1[1]); w.w = pg8::cvt_pk_bf16(v1[2], v1[3]);
                    *(v4u*)(rowp + bj * 128) = w; }
                asm volatile("" ::: "memory"); }
    }
};

__device__ __forceinline__ void transpose_item(const float* W, int K, int Npitch, int nblk, bf16* WT, LAS float* scr, int item, int lane, bool win) {
    const int kb = item / nblk, nb = item % nblk, k0 = 64 * kb, n0 = 32 * nb;
    const int ns = win ? (n0 < 3072 ? n0 : n0 + 16) : n0;
#pragma unroll 8
    for (int i = 0; i < 32; ++i) { const int kk = 2 * i + (lane >> 5); scr[kk * 33 + (lane & 31)] = W[(size_t)(k0 + kk) * Npitch + ns + (lane & 31)]; }
    LDS_WAIT(); asm volatile("" ::: "memory");
    const int c = lane & 7;
#pragma unroll
    for (int j = 0; j < 4; ++j) { const int n = (lane >> 3) + 8 * j; const LAS float* s = scr + (8 * c) * 33 + n;
        v4u o; o.x = pk2(s[0 * 33], s[1 * 33]); o.y = pk2(s[2 * 33], s[3 * 33]); o.z = pk2(s[4 * 33], s[5 * 33]); o.w = pk2(s[6 * 33], s[7 * 33]);
        *(v4u*)(WT + (size_t)(n0 + n) * K + k0 + 8 * c) = o; }
    LDS_WAIT(); asm volatile("" ::: "memory");
}

__device__ __forceinline__ void phase_p0(const Args& a, LAS unsigned char* lds, int tid, int lane, int wave, int vcu, int G) {
    float* modx = (float*)(a.ws + WS_MODX); float* modc = (float*)(a.ws + WS_MODC);
    if (blockIdx.x < 96) {
        const float* c = a.in[I_C]; const float* cctx = a.in[I_CCTX]; const float* wmod = a.in[I_WMOD]; const float* bmod = a.in[I_BMOD];
        LAS float* sc = (LAS float*)lds;
        for (int i = tid; i < 17 * 1024; i += 512) { const float v = i < 16 * 1024 ? c[i] : cctx[i - 16 * 1024]; sc[i] = v / (1.f + expf(-v)); }
        __syncthreads();
        const int n = blockIdx.x * 64 + lane;
        float acc[17];
#pragma unroll
        for (int b = 0; b < 17; ++b) acc[b] = 0.f;
        const int k0 = wave * 128;
        for (int kk = 0; kk < 128; ++kk) { const int k = k0 + kk; const float w = wmod[(size_t)k * 6144 + n];
#pragma unroll
            for (int b = 0; b < 17; ++b) acc[b] += sc[b * 1024 + k] * w; }
        LAS float* red = (LAS float*)(lds + 69632);
#pragma unroll
        for (int b = 0; b < 17; ++b) red[(wave * 17 + b) * 64 + lane] = acc[b];
        __syncthreads();
        for (int i = tid; i < 17 * 64; i += 512) { const int b = i >> 6, l = i & 63; float s = 0.f;
#pragma unroll
            for (int w = 0; w < 8; ++w) s += red[(w * 17 + b) * 64 + l];
            const int nn = blockIdx.x * 64 + l; s += bmod[nn];
            if (b < 16) modx[(size_t)b * 6144 + nn] = s; else if (nn < 2048) modc[nn] = s; }
        __syncthreads();
    }
    LAS float* scr = (LAS float*)(lds + wave * 8448);
    const int gw = vcu * NWAVES + wave, NGW = G * NWAVES;
    constexpr int I_IN = 16 * 256, I_SQ = 16 * 32, I_1 = 16 * 128, I_2 = 64 * 32;
    constexpr int NITEMS = I_IN + 3 * I_SQ + I_1 + I_2;
    for (int it = gw; it < NITEMS; it += NGW) {
        int r = it;
        if (r < I_IN) { transpose_item(a.in[I_WIN], DM, PT, 256, (bf16*)(a.ws + WS_WIN), scr, r, lane, true); continue; } r -= I_IN;
        if (r < I_SQ) { transpose_item(a.in[I_WA], DM, DM, 32, (bf16*)(a.ws + WS_WA), scr, r, lane, false); continue; } r -= I_SQ;
        if (r < I_SQ) { transpose_item(a.in[I_WB], DM, DM, 32, (bf16*)(a.ws + WS_WB), scr, r, lane, false); continue; } r -= I_SQ;
        if (r < I_SQ) { transpose_item(a.in[I_WOUT], DM, DM, 32, (bf16*)(a.ws + WS_WOUT), scr, r, lane, false); continue; } r -= I_SQ;
        if (r < I_1) { transpose_item(a.in[I_W1], DM, FF, 128, (bf16*)(a.ws + WS_W1), scr, r, lane, false); continue; } r -= I_1;
        transpose_item(a.in[I_W2], FF, DM, 32, (bf16*)(a.ws + WS_W2), scr, r, lane, false);
    }
}

__device__ __forceinline__ void phase_b1(const Args& a, LAS unsigned char* lds, int g, int tid, int lane, int wave, int vcu, int G) {
    LAS float* wgT = (LAS float*)lds;
    { const float* win = a.in[I_WIN];
      for (int i = tid; i < 16384; i += 512) { const int k = i >> 4, gi = i & 15; wgT[gi * 1024 + k] = win[(size_t)k * PT + 3072 + gi]; } }
    __syncthreads();
    const float* modx = (const float*)(a.ws + WS_MODX); const float* modc = (const float*)(a.ws + WS_MODC);
    const float* norm1 = a.in[I_NORM1]; const float* bgate = a.in[I_BGATE];
    bf16* XN = (bf16*)(a.ws + WS_XN); float* GATES = (float*)(a.ws + WS_GATES);
    const int gw = vcu * NWAVES + wave, NGW = G * NWAVES;
    for (int row = gw; row < RT; row += NGW) {
        const float* src; const float* sh; const float* sc;
        if (row < RL) { const int b = g * GBAT + (row >> 11), t = row & 2047; src = a.in[I_X] + ((size_t)b * SEQ + t) * DM; sh = modx + (size_t)b * 6144; sc = sh + 1024; }
        else { const int rr = row - RL, b = g * GBAT + (rr >> 8), t = rr & 255; src = a.in[I_CTX] + ((size_t)b * CTXL + t) * DM; sh = modc; sc = modc + 1024; }
        f32x4 v[4]; float ss = 0.f;
#pragma unroll
        for (int j = 0; j < 4; ++j) { v[j] = *(const f32x4*)(src + 4 * lane + 256 * j); ss += (v[j].x * v[j].x + v[j].y * v[j].y) + (v[j].z * v[j].z + v[j].w * v[j].w); }
        const float rstd = rsqrtf(wave_sum(ss) * (1.f / DM) + EPS);
#pragma unroll
        for (int j = 0; j < 4; ++j) { const f32x4 n1 = *(const f32x4*)(norm1 + 4 * lane + 256 * j), s1 = *(const f32x4*)(sc + 4 * lane + 256 * j), h1 = *(const f32x4*)(sh + 4 * lane + 256 * j);
            v[j] = v[j] * rstd * n1 * (s1 + 1.f) + h1;
            v2u o; o.x = pk2(v[j].x, v[j].y); o.y = pk2(v[j].z, v[j].w);
            *(v2u*)(XN + (size_t)row * DM + 4 * lane + 256 * j) = o; }
        float mine = 0.f;
#pragma unroll 1
        for (int gi = 0; gi < 16; ++gi) { float p = 0.f;
#pragma unroll
            for (int j = 0; j < 4; ++j) { const f32x4 w4 = *(const LAS f32x4*)(wgT + gi * 1024 + 256 * j + 4 * lane); p += (v[j].x * w4.x + v[j].y * w4.y) + (v[j].z * w4.z + v[j].w * w4.w); }
            p = wave_sum(p); if (lane == gi) mine = p; }
        if (lane < 16) { float val = mine + bgate[lane]; if ((lane >> 2) & 1) val = logsigmoidf_(val); GATES[(size_t)row * 16 + lane] = val; }
    }
}

__device__ __forceinline__ void phase_b3_naive(const Args& a, LAS unsigned char* lds, int g, int tid, int lane, int wave, int vcu, int G) {
    const bf16* Q = (const bf16*)(a.ws + WS_Q); const bf16* K = (const bf16*)(a.ws + WS_K);
    bf16* QP = (bf16*)(a.ws + WS_QP); bf16* KP = (bf16*)(a.ws + WS_KP);
    const float* conv = a.in[I_CONV];
    const size_t nitem = (size_t)RT * 256;
    for (size_t it = (size_t)vcu * 512 + tid; it < nitem; it += (size_t)G * 512) {
        const int row = (int)(it >> 8), cg = (int)(it & 255), which = cg >> 7, c0 = (cg & 127) * 8;
        int t, L; if (row < RL) { t = row & 2047; L = SEQ; } else { t = (row - RL) & 255; L = CTXL; }
        const bf16* src = which ? K : Q;
        const v4u z = {0u, 0u, 0u, 0u};
        const v4u r1 = *(const v4u*)(src + (size_t)row * DM + c0);
        const v4u r0 = t > 0 ? *(const v4u*)(src + (size_t)(row - 1) * DM + c0) : z;
        const v4u r2 = t < L - 1 ? *(const v4u*)(src + (size_t)(row + 1) * DM + c0) : z;
        const float* w0 = conv + which * 1024 + c0; const float* w1 = w0 + 2048; const float* w2 = w0 + 4096;
        const unsigned a0[4] = {r0.x, r0.y, r0.z, r0.w}, a1[4] = {r1.x, r1.y, r1.z, r1.w}, a2[4] = {r2.x, r2.y, r2.z, r2.w};
        float o[8];
#pragma unroll
        for (int e = 0; e < 4; ++e) {
            const float s0 = bflo(a0[e]) * w0[2 * e] + bflo(a1[e]) * w1[2 * e] + bflo(a2[e]) * w2[2 * e];
            const float s1 = bfhi(a0[e]) * w0[2 * e + 1] + bfhi(a1[e]) * w1[2 * e + 1] + bfhi(a2[e]) * w2[2 * e + 1];
            o[2 * e] = siluf_(s0); o[2 * e + 1] = siluf_(s1); }
        const float scl = which ? 0.0625f : 1.f;
        v4u w; w.x = pk2(o[0] * scl, o[1] * scl); w.y = pk2(o[2] * scl, o[3] * scl); w.z = pk2(o[4] * scl, o[5] * scl); w.w = pk2(o[6] * scl, o[7] * scl);
        *(v4u*)((which ? KP : QP) + (size_t)row * DM + c0) = w;
    }
    const bf16* VG = (const bf16*)(a.ws + WS_VG); bf16* U = (bf16*)(a.ws + WS_U);
    const float* wsp = a.in[I_WS]; const float* bsp = a.in[I_BS]; const float* gsgu = a.in[I_GSGU];
    LAS float* vnL = (LAS float*)lds;
    LAS float* rs = (LAS float*)(lds + 65536);
    for (int task = blockIdx.x; task < GBAT * 16; task += G) {
        const int bl = task >> 4, n = task & 15, r0 = bl * SEQ + n * 128;
        for (int i = 0; i < 16; ++i) { const int q = wave * 16 + i; float ss = 0.f;
#pragma unroll
            for (int j = 0; j < 2; ++j) { const v4u w = *(const v4u*)(VG + (size_t)(r0 + q) * DM + (j * 64 + lane) * 8);
                const float f[8] = {bflo(w.x), bfhi(w.x), bflo(w.y), bfhi(w.y), bflo(w.z), bfhi(w.z), bflo(w.w), bfhi(w.w)};
#pragma unroll
                for (int e = 0; e < 8; ++e) ss += f[e] * f[e]; }
            ss = wave_sum(ss); if (lane == 0) rs[q] = rsqrtf(ss * (1.f / DM) + EPS); }
        __syncthreads();
        for (int gg = 0; gg < 8; ++gg) {
            for (int i = 0; i < 4; ++i) { const int ci = tid + 512 * i, q = ci >> 4, cc = ci & 15;
                const v4u w = *(const v4u*)(VG + (size_t)(r0 + q) * DM + gg * 128 + cc * 8);
                const float f[8] = {bflo(w.x), bfhi(w.x), bflo(w.y), bfhi(w.y), bflo(w.z), bfhi(w.z), bflo(w.w), bfhi(w.w)};
                const float r = rs[q];
#pragma unroll
                for (int e = 0; e < 8; ++e) vnL[q * 128 + cc * 8 + e] = f[e] * r * gsgu[gg * 128 + cc * 8 + e]; }
            __syncthreads();
            const int c = tid & 127, pq = tid >> 7;
            for (int i = 0; i < 32; ++i) { const int p = pq + 4 * i; float s = bsp[gg * 128 + p];
                const float* wr_ = wsp + ((size_t)gg * 128 + p) * 128;
                for (int q = 0; q < 128; ++q) s += wr_[q] * vnL[q * 128 + c];
                bf16* up = U + (size_t)(r0 + p) * DM + gg * 128 + c;
                *up = (bf16)f2bf(bf2f(*up) * s); }
            __syncthreads();
        }
    }
}

__device__ __forceinline__ void phase_b4_naive(const Args& a, LAS unsigned char* lds, int g, int tid, int lane, int wave, int G) {
    const bf16* QP = (const bf16*)(a.ws + WS_QP); const bf16* KP = (const bf16*)(a.ws + WS_KP); const bf16* V = (const bf16*)(a.ws + WS_V);
    const float* GATES = (const float*)(a.ws + WS_GATES);
    float* HF = a.out + (size_t)g * RL * DM; float* HB = (float*)(a.ws + WS_HB);
    LAS float* ks = (LAS float*)lds;
    LAS float* qs = ks + 512;
    LAS float* hps = qs + 512;
    LAS float* dens = hps + 1024;
    const int v = tid & 127, dq = tid >> 7;
    for (int task = blockIdx.x; task < GBAT * NHEAD * 4; task += G) {
        const int bl = task >> 4, h = (task >> 2) & 3, dir = (task >> 1) & 1, vh = task & 1;
        float* Hd = dir ? HB : HF;
        float C[64];
#pragma unroll
        for (int i = 0; i < 64; ++i) C[i] = 0.f;
        float nst = 0.f;
        __syncthreads();
        for (int s = 0; s < CTXL + SEQ; ++s) {
            const int par = s & 1;
            int row; bool outp;
            if (s < CTXL) { const int t = dir ? CTXL - 1 - s : s; row = RL + bl * CTXL + t; outp = false; }
            else { int t = s - CTXL; if (dir) t = SEQ - 1 - t; row = bl * SEQ + t; outp = true; }
            const float li = GATES[(size_t)row * 16 + dir * 8 + h], lf = GATES[(size_t)row * 16 + dir * 8 + 4 + h];
            const float f = __expf(lf), ig = __expf(li);
            if (tid < 256) { ks[par * 256 + tid] = bf2f(KP[(size_t)row * DM + h * HD + tid]); qs[par * 256 + tid] = bf2f(QP[(size_t)row * DM + h * HD + tid]); }
            const float vv = bf2f(V[(size_t)row * DM + h * HD + vh * 128 + v]) * ig;
            __syncthreads();
            float hp = 0.f;
            const LAS float* kp = ks + par * 256 + 64 * dq; const LAS float* qp = qs + par * 256 + 64 * dq;
#pragma unroll
            for (int dd = 0; dd < 64; ++dd) { C[dd] = f * C[dd] + kp[dd] * vv; hp += qp[dd] * C[dd]; }
            if (tid < 256) { nst = f * nst + ig * ks[par * 256 + tid]; const float ds = wave_sum(qs[par * 256 + tid] * nst); if (lane == 0) dens[par * 4 + wave] = ds; }
            hps[(par * 4 + dq) * 128 + v] = hp;
            __syncthreads();
            if (outp && tid < 128) { const float den = (dens[par * 4 + 0] + dens[par * 4 + 1]) + (dens[par * 4 + 2] + dens[par * 4 + 3]);
                const float num = (hps[(par * 4 + 0) * 128 + v] + hps[(par * 4 + 1) * 128 + v]) + (hps[(par * 4 + 2) * 128 + v] + hps[(par * 4 + 3) * 128 + v]);
                Hd[(size_t)row * DM + h * HD + vh * 128 + v] = num / fmaxf(fabsf(den), 1.f); }
        }
    }
}

__device__ __forceinline__ void phase_b5_naive(const Args& a, int g, int lane, int wave, int vcu, int G) {
    bf16* O = (bf16*)(a.ws + WS_O); const float* HF = a.out + (size_t)g * RL * DM; const float* HB = (const float*)(a.ws + WS_HB);
    const float* gmh = a.in[I_GMH];
    const int gw = vcu * NWAVES + wave, NGW = G * NWAVES;
    for (int row = gw; row < RL; row += NGW) {
#pragma unroll
        for (int j = 0; j < 4; ++j) { const size_t off = (size_t)row * DM + 256 * j + 4 * lane;
            const v2u ow = *(const v2u*)(O + off); const f32x4 hf = *(const f32x4*)(HF + off), hb = *(const f32x4*)(HB + off);
            f32x4 z; z.x = sigmoidf_(bflo(ow.x)) * (hf.x + hb.x); z.y = sigmoidf_(bfhi(ow.x)) * (hf.y + hb.y); z.z = sigmoidf_(bflo(ow.y)) * (hf.z + hb.z); z.w = sigmoidf_(bfhi(ow.y)) * (hf.w + hb.w);
            const float ss = wave_sum((z.x * z.x + z.y * z.y) + (z.z * z.z + z.w * z.w));
            const float rstd = rsqrtf(ss * (1.f / HD) + EPS);
            const f32x4 gm = *(const f32x4*)(gmh + 256 * j + 4 * lane);
            z = z * rstd * gm;
            v2u o; o.x = pk2(z.x, z.y); o.y = pk2(z.z, z.w);
            *(v2u*)(O + off) = o; }
    }
}

__device__ __forceinline__ void phase_b8(const Args& a, int g, int lane, int wave, int vcu, int G) {
    const float* X1 = a.out + (size_t)g * RL * DM; bf16* XN = (bf16*)(a.ws + WS_XN);
    const float* modx = (const float*)(a.ws + WS_MODX); const float* norm2 = a.in[I_NORM2];
    const int gw = vcu * NWAVES + wave, NGW = G * NWAVES;
    for (int row = gw; row < RL; row += NGW) {
        const int b = g * GBAT + (row >> 11);
        const float* sh = modx + (size_t)b * 6144 + 3 * 1024; const float* sc = sh + 1024;
        f32x4 v[4]; float ss = 0.f;
#pragma unroll
        for (int j = 0; j < 4; ++j) { v[j] = *(const f32x4*)(X1 + (size_t)row * DM + 4 * lane + 256 * j); ss += (v[j].x * v[j].x + v[j].y * v[j].y) + (v[j].z * v[j].z + v[j].w * v[j].w); }
        const float rstd = rsqrtf(wave_sum(ss) * (1.f / DM) + EPS);
#pragma unroll
        for (int j = 0; j < 4; ++j) { const f32x4 n2 = *(const f32x4*)(norm2 + 4 * lane + 256 * j), s2 = *(const f32x4*)(sc + 4 * lane + 256 * j), h2 = *(const f32x4*)(sh + 4 * lane + 256 * j);
            const f32x4 y = v[j] * rstd * n2 * (s2 + 1.f) + h2;
            v2u o; o.x = pk2(y.x, y.y); o.y = pk2(y.z, y.w);
            *(v2u*)(XN + (size_t)row * DM + 4 * lane + 256 * j) = o; }
    }
}
__device__ __forceinline__ void phase_b11(const Args& a, int g, int lane, int wave, int vcu, int G) {
    float* X2 = a.out + (size_t)g * RL * DM; const float* normf = a.in[I_NORMF];
    const int gw = vcu * NWAVES + wave, NGW = G * NWAVES;
    for (int row = gw; row < RL; row += NGW) {
        f32x4 v[4]; float ss = 0.f;
#pragma unroll
        for (int j = 0; j < 4; ++j) { v[j] = *(const f32x4*)(X2 + (size_t)row * DM + 4 * lane + 256 * j); ss += (v[j].x * v[j].x + v[j].y * v[j].y) + (v[j].z * v[j].z + v[j].w * v[j].w); }
        const float rstd = rsqrtf(wave_sum(ss) * (1.f / DM) + EPS);
#pragma unroll
        for (int j = 0; j < 4; ++j) { const f32x4 nf = *(const f32x4*)(normf + 4 * lane + 256 * j);
            *(f32x4*)(X2 + (size_t)row * DM + 4 * lane + 256 * j) = v[j] * rstd * nf; }
    }
}

#define PHASE_IDS() int tid_p = tid, wave_p = wave, vcu_p = vcu, bx_p = bx; asm volatile("" : "+v"(tid_p), "+s"(wave_p), "+s"(vcu_p), "+s"(bx_p)); const int lane_p = tid_p & 63; (void)lane_p
__global__ void __launch_bounds__(NWAVES * 64, 2) fwd(Args a) {
    extern __shared__ __attribute__((aligned(16))) unsigned char lds_raw[];
    LAS unsigned char* lds = (LAS unsigned char*)lds_raw;
    const int tid = threadIdx.x, lane = tid & 63, wave = __builtin_amdgcn_readfirstlane(tid >> 6);
    const int G = gridDim.x; const int bx = blockIdx.x; const int vcu = (G % 8 == 0) ? (bx % 8) * (G / 8) + bx / 8 : bx;
    volatile LAS unsigned* MISC = (volatile LAS unsigned*)(lds + MISC_OFF);
    for (int u = tid; u < (LDS_BYTES - LDSCTL_OFF) / 4; u += NWAVES * 64) ((LAS unsigned*)(lds + LDSCTL_OFF))[u] = 0u;
    __syncthreads();
    XcdBarrier bar; bar.bar = (unsigned*)(a.ws + WS_CTL) + CW_BAR; bar.x = 0; bar.st = nullptr;
    if (a.ph_hi - a.ph_lo > 1) bar = xcd_barrier_post((unsigned*)(a.ws + WS_CTL) + CW_BAR, MISC + 8);
    const int lo = a.ph_lo, hi = a.ph_hi;
#ifndef PHASE_MASK
#define PHASE_MASK 0xFFF
#endif
#define ON(k) ((PHASE_MASK >> (k)) & 1)
#define IN(k) (lo <= (k) && (k) < hi)
#define SEAM(k) do { if (IN(k) && IN((k) + 1)) xcd_barrier(bar); } while (0)
    typedef pg8::bf16_t pb;
    if (ON(11) && IN(0)) { PHASE_IDS(); phase_p0(a, lds, tid_p, lane_p, wave_p, vcu_p, G); SEAM(0); }
    for (int g = 0; g < NGRP; ++g) {
        const int pb0 = 1 + g * NPG;
        if (ON(0) && IN(pb0 + 0)) { PHASE_IDS(); phase_b1(a, lds, g, tid_p, lane_p, wave_p, vcu_p, G); SEAM(pb0 + 0); }
        if (ON(1) && IN(pb0 + 1)) { PHASE_IDS();
            pg8::Gemm gm{(const pb*)(a.ws + WS_XN), (const pb*)(a.ws + WS_WIN), RT, 8192, DM}; Gemm1Order S; S.init(G, bx_p); EpiPx E{a.ws};
            pg8::gemm_phase<EpiPx, Gemm1Order, true, true>(lds, gm, S, E);
            SEAM(pb0 + 1); }
        if (ON(2) && IN(pb0 + 2)) { PHASE_IDS(); phase_b3_naive(a, lds, g, tid_p, lane_p, wave_p, vcu_p, G); SEAM(pb0 + 2); }
        if (ON(3) && IN(pb0 + 3)) { PHASE_IDS(); phase_b4_naive(a, lds, g, tid_p, lane_p, wave_p, G); SEAM(pb0 + 3); }
        if (ON(4) && IN(pb0 + 4)) { PHASE_IDS(); phase_b5_naive(a, g, lane_p, wave_p, vcu_p, G); SEAM(pb0 + 4); }
        if (ON(5) && IN(pb0 + 5)) { PHASE_IDS();
            { pg8::Gemm gm{(const pb*)(a.ws + WS_O), (const pb*)(a.ws + WS_WA), RL, DM, DM}; pg8::StaticOrder S; S.init(RL, DM, G, bx_p);
              EpiGate<0> E{(const bf16*)(a.ws + WS_GA), (bf16*)(a.ws + WS_GA)};
              pg8::gemm_phase<EpiGate<0>, pg8::StaticOrder, false, true>(lds, gm, S, E); }
            { pg8::Gemm gm{(const pb*)(a.ws + WS_U), (const pb*)(a.ws + WS_WB), RL, DM, DM}; pg8::StaticOrder S; S.init(RL, DM, G, bx_p);
              EpiGate<1> E{(const bf16*)(a.ws + WS_GB), (bf16*)(a.ws + WS_GA)};
              pg8::gemm_phase<EpiGate<1>, pg8::StaticOrder, false, true>(lds, gm, S, E); }
            SEAM(pb0 + 5); }
        if (ON(6) && IN(pb0 + 6)) { PHASE_IDS();
            pg8::Gemm gm{(const pb*)(a.ws + WS_GA), (const pb*)(a.ws + WS_WOUT), RL, DM, DM}; pg8::StaticOrder S; S.init(RL, DM, G, bx_p);
            EpiRes E{a.in[I_X], a.out, (const float*)(a.ws + WS_MODX), 2 * 1024, g * RL};
            pg8::gemm_phase<EpiRes, pg8::StaticOrder, false, true>(lds, gm, S, E);
            SEAM(pb0 + 6); }
        if (ON(7) && IN(pb0 + 7)) { PHASE_IDS(); phase_b8(a, g, lane_p, wave_p, vcu_p, G); SEAM(pb0 + 7); }
        if (ON(8) && IN(pb0 + 8)) { PHASE_IDS();
            pg8::Gemm gm{(const pb*)(a.ws + WS_XN), (const pb*)(a.ws + WS_W1), RL, FF, DM}; pg8::StaticOrder S; S.init(RL, FF, G, bx_p);
            EpiRelu2 E{(bf16*)(a.ws + WS_H1)};
            pg8::gemm_phase<EpiRelu2, pg8::StaticOrder, true, true>(lds, gm, S, E);
            SEAM(pb0 + 8); }
        if (ON(9) && IN(pb0 + 9)) { PHASE_IDS();
            pg8::Gemm gm{(const pb*)(a.ws + WS_H1), (const pb*)(a.ws + WS_W2), RL, DM, FF}; pg8::StaticOrder S; S.init(RL, DM, G, bx_p);
            EpiRes E{a.out, a.out, (const float*)(a.ws + WS_MODX), 5 * 1024, g * RL};
            pg8::gemm_phase<EpiRes, pg8::StaticOrder, false, true>(lds, gm, S, E);
            SEAM(pb0 + 9); }
        if (ON(10) && IN(pb0 + 10)) { PHASE_IDS(); phase_b11(a, g, lane_p, wave_p, vcu_p, G); SEAM(pb0 + 10); }
    }
#undef IN
#undef SEAM
}

extern "C" void kernel_launch(void* const* d_in, const int* in_sizes, int n_in, void* d_out, int out_size, void* d_ws, size_t ws_size, hipStream_t stream) {
    static int grid = 0;
    if (grid == 0) {
        if (n_in != 21 || out_size != BATCH * SEQ * DM || ws_size < WS_END) { fprintf(stderr, "kernel_launch: unexpected shapes (n_in %d, out %d, ws %zu < %zu)\n", n_in, out_size, ws_size, (size_t)WS_END); grid = -1; return; }
        int dev = 0, cus = 0, per_cu = 0;
        if (hipGetDevice(&dev) != hipSuccess || hipDeviceGetAttribute(&cus, hipDeviceAttributeMultiprocessorCount, dev) != hipSuccess) { grid = -1; return; }
        if (hipFuncSetAttribute((const void*)fwd, hipFuncAttributeMaxDynamicSharedMemorySize, LDS_BYTES) != hipSuccess) { fprintf(stderr, "kernel_launch: hipFuncSetAttribute failed\n"); grid = -1; return; }
        if (hipOccupancyMaxActiveBlocksPerMultiprocessor(&per_cu, (const void*)fwd, NWAVES * 64, LDS_BYTES) != hipSuccess || per_cu < 1) { fprintf(stderr, "kernel_launch: occupancy query says %d\n", per_cu); per_cu = 1; }
        (void)hipGetLastError();
        grid = cus * (per_cu < 1 ? per_cu : 1);
    }
    if (grid < 0) return;
    (void)hipMemsetAsync((char*)d_ws + WS_CTL, 0, CTL_ZERO_BYTES, stream);
    Args a{};
    for (int i = 0; i < 21; ++i) a.in[i] = (const float*)d_in[i];
    a.out = (float*)d_out; a.ws = (unsigned char*)d_ws;
#if MK_N_LAUNCHES == 1
    a.ph_lo = 0; a.ph_hi = NPHASE;
    { void* kargs[] = {(void*)&a};
      hipError_t e = hipLaunchCooperativeKernel((const void*)fwd, dim3(grid), dim3(NWAVES * 64), kargs, LDS_BYTES, stream);
      if (e != hipSuccess) fprintf(stderr, "kernel_launch: cooperative launch failed: %s (grid %d)\n", hipGetErrorString(e), grid); }
#else
    for (int p = 0; p < NPHASE; ++p) { a.ph_lo = p; a.ph_hi = p + 1; hipLaunchKernelGGL(fwd, dim3(grid), dim3(NWAVES * 64), LDS_BYTES, stream, a); }
#endif
}
```

```cpp
#include <hip/hip_runtime.h>
#include <cstdio>
#include <cstdint>
namespace pg8 {
#define PG8_LAS __attribute__((address_space(3)))
typedef unsigned short bf16_t;
typedef short bf16x8 __attribute__((ext_vector_type(8)));
typedef float f32x4 __attribute__((ext_vector_type(4)));
typedef unsigned u32x4 __attribute__((ext_vector_type(4)));
constexpr int BM = 256, BK = 64, HALF = 128, HTB = HALF * BK * 2  , STAGE_BYTES = 8 * HTB, NXCD = 8, WGM = 8;

__host__ __device__ __forceinline__ int lds_byte(int r, int c) { const int st = (r >> 4) * 2 + (c >> 5), rr = r & 15, cc = c & 31, ob = rr * 64 + cc * 2; return st * 1024 + (ob ^ (((ob >> 9) & 1) << 5)); }
__host__ __device__ __forceinline__ void stage_rc(int b, int& R, int& C) { const int st = b / 1024, sb = b % 1024, swz = sb ^ (((sb >> 9) & 1) << 5); R = (st >> 1) * 16 + swz / 64; C = (st & 1) * 32 + (swz % 64) / 2; }
__host__ __device__ __forceinline__ int perm32(int rho) { const int n = rho >> 4, i = rho & 15; return 8 * (i >> 2) + 4 * n + (i & 3); }

struct Unit { int pm, pn, kind; };
struct Gemm { const bf16_t* A; const bf16_t* Bt; int M, N, K; };

struct StaticOrder {
    int nM, nN, nwg, G, c;
    __host__ __device__ void init(int M, int N, int G_, int c_) { nM = M / BM; nN = N / BM; nwg = nM * nN; G = G_; c = c_; }
    __host__ __device__ bool next(int i, Unit& u) const {
        const long L = (long)i * G + c; if (L >= nwg) return false;
        int wgid = (int)L; { const int q = nwg / NXCD, r = nwg % NXCD, xcd = wgid % NXCD, off = wgid / NXCD; wgid = (xcd < r ? xcd * (q + 1) : r * (q + 1) + (xcd - r) * q) + off; }
        const int nig = WGM * nN, gid = wgid / nig, fm = gid * WGM, gsz = (nM - fm) < WGM ? (nM - fm) : WGM;
        u.pm = fm + ((wgid % nig) % gsz); u.pn = (wgid % nig) / gsz; u.kind = 0; return true;
    }
    __device__ __forceinline__ void a_ready(const Unit&) const {}
    __device__ __forceinline__ void done(const Unit&) const {}
    __device__ __forceinline__ const char* pa(const Gemm& g, const Unit& u, size_t tstep) const { return (const char*)g.A + (size_t)u.pm * tstep; }
    __device__ __forceinline__ const char* pb(const Gemm& g, const Unit& u, size_t tstep) const { return (const char*)g.Bt + (size_t)u.pn * tstep; }
};
__device__ __forceinline__ unsigned cvt_pk_bf16(float lo, float hi) { unsigned r; asm volatile("v_cvt_pk_bf16_f32 %0, %1, %2" : "=v"(r) : "v"(lo), "v"(hi)); return r; }
typedef float f32x2 __attribute__((ext_vector_type(2)));
template <class Epi, class Sched, bool ALIGN_EPI = false, bool SP2 = false>
__device__ __forceinline__ void gemm_phase(PG8_LAS unsigned char* lds, const Gemm g, const Sched& S, const Epi& E) {
    int tid_ = threadIdx.x; asm volatile("" : "+v"(tid_));
    const int tid = tid_, wid = __builtin_amdgcn_readfirstlane(tid >> 6), lane = tid & 63, wr = wid >> 2, wc = wid & 3, fr = lane & 15, fq = lane >> 4;
    const int K = g.K, nt = K / BK;
    unsigned voffA[2], voffB[2];
#pragma unroll
    for (int i = 0; i < 2; ++i) { int R, C; stage_rc(tid * 16 + i * 8192, R, C); const int Rb = Epi::PERM ? ((R & ~31) + perm32(R & 31)) : R;
        voffA[i] = (unsigned)(R * K + C) * 2u; voffB[i] = (unsigned)(Rb * K + C) * 2u; }
    const size_t kstep = (size_t)(BK * 2);
    const size_t hstep = (size_t)HALF * K * 2;
    const size_t tstep = 2 * hstep;
    const unsigned ldsw = (unsigned)wid * 1024u;
    const int aoff = lds_byte(wr * 64 + fr, fq * 8), boff = lds_byte(wc * 32 + fr, fq * 8);
#define PG8_SA(b, h) (((b) * 2 + (h)) * HTB)
#define PG8_SB(b, h) ((4 + (b) * 2 + (h)) * HTB)
#define PG8_STAGE(bufoff, gbase, voff) do { _Pragma("unroll") for (int _i = 0; _i < 2; ++_i) \
        __builtin_amdgcn_global_load_lds((const unsigned*)((const char*)(gbase) + (voff)[_i]), (PG8_LAS unsigned*)(lds + (bufoff) + ldsw + _i * 8192), 16, 0, 0); } while (0)
#define PG8_LDA(dst, b, h) do { _Pragma("unroll") for (int m = 0; m < 4; ++m) _Pragma("unroll") for (int k = 0; k < 2; ++k) dst[m][k] = *(const PG8_LAS bf16x8*)(lds + PG8_SA(b, h) + aoff + m * 2048 + k * 1024); } while (0)
#define PG8_LDB(dst, b, h) do { _Pragma("unroll") for (int n = 0; n < 2; ++n) _Pragma("unroll") for (int k = 0; k < 2; ++k) dst[n][k] = *(const PG8_LAS bf16x8*)(lds + PG8_SB(b, h) + boff + n * 2048 + k * 1024); } while (0)
#define PG8_MMA(ai, bj, At, Bt) do { __builtin_amdgcn_s_setprio(1); _Pragma("unroll") for (int m = 0; m < 4; ++m) _Pragma("unroll") for (int n = 0; n < 2; ++n) _Pragma("unroll") for (int k = 0; k < 2; ++k) \
        acc[ai][bj][m][n] = __builtin_amdgcn_mfma_f32_16x16x32_bf16(Bt[n][k], At[m][k], acc[ai][bj][m][n], 0, 0, 0); __builtin_amdgcn_s_setprio(0); } while (0)
#define PG8_WAIT_V(n) asm volatile("s_waitcnt vmcnt(" #n ")" ::: "memory")
#define PG8_WAIT_L(n) asm volatile("s_waitcnt lgkmcnt(" #n ")" ::: "memory")
#define PG8_BAR __builtin_amdgcn_s_barrier()
#define PG8_SCHED __builtin_amdgcn_sched_barrier(0)
    Unit cur, nxt; int ui = 0;
    if (!S.next(0, cur)) return;
    f32x4 acc[2][2][4][2];
#pragma unroll
    for (int a = 0; a < 2; ++a)
#pragma unroll
        for (int b = 0; b < 2; ++b)
#pragma unroll
            for (int m = 0; m < 4; ++m)
#pragma unroll
                for (int n = 0; n < 2; ++n) acc[a][b][m][n] = (f32x4){0.f, 0.f, 0.f, 0.f};
    bf16x8 At[4][2], B0[2][2], B1[2][2];
    const char* cA = S.pa(g, cur, tstep); const char* cB = S.pb(g, cur, tstep);
    S.a_ready(cur);
    if constexpr (SP2) {
        PG8_STAGE(PG8_SB(0, 0), cB, voffB); PG8_STAGE(PG8_SB(0, 1), cB + hstep, voffB); PG8_STAGE(PG8_SA(0, 0), cA, voffA); PG8_STAGE(PG8_SA(0, 1), cA + hstep, voffA);
        if (wr == 1) PG8_BAR;
        PG8_WAIT_V(2); PG8_BAR;
        PG8_STAGE(PG8_SB(1, 0), cB + kstep, voffB); PG8_STAGE(PG8_SA(1, 0), cA + kstep, voffA); PG8_STAGE(PG8_SB(1, 1), cB + hstep + kstep, voffB);
        PG8_WAIT_V(6); PG8_BAR;
    } else {
        PG8_STAGE(PG8_SB(0, 0), cB, voffB); PG8_STAGE(PG8_SA(0, 0), cA, voffA); PG8_STAGE(PG8_SB(0, 1), cB + hstep, voffB); PG8_STAGE(PG8_SA(0, 1), cA + hstep, voffA);
        if (wr == 1) PG8_BAR;
        PG8_WAIT_V(4); PG8_BAR;
        PG8_STAGE(PG8_SB(1, 0), cB + kstep, voffB); PG8_STAGE(PG8_SA(1, 0), cA + kstep, voffA); PG8_STAGE(PG8_SB(1, 1), cB + hstep + kstep, voffB);
        PG8_WAIT_V(6); PG8_BAR;
    }
    for (;;) {
        const bool has_next = S.next(ui + 1, nxt);
        const char* nA = has_next ? S.pa(g, nxt, tstep) : cA; const char* nB = has_next ? S.pb(g, nxt, tstep) : cB;
        for (int t = 0; t < nt; t += 2) {
            const bool last = (t == nt - 2);
            const char* a1 = cA + (size_t)(t + 1) * kstep;
            const char* a2 = last ? nA : cA + (size_t)(t + 2) * kstep; const char* b2 = last ? nB : cB + (size_t)(t + 2) * kstep;
            const char* a3 = a2 + kstep; const char* b3 = b2 + kstep;
            if (last && has_next) S.a_ready(nxt);
            if constexpr (SP2) {
            PG8_LDB(B0, 0, 0); PG8_LDB(B1, 0, 1); PG8_SCHED; PG8_LDA(At, 0, 0); PG8_STAGE(PG8_SA(1, 1), a1 + hstep, voffA);
            PG8_WAIT_V(8); PG8_WAIT_L(0); PG8_BAR; PG8_MMA(0, 0, At, B0); PG8_MMA(0, 1, At, B1); PG8_BAR; PG8_SCHED;
            PG8_LDA(At, 0, 1); PG8_STAGE(PG8_SB(0, 0), b2, voffB); PG8_STAGE(PG8_SB(0, 1), b2 + hstep, voffB); PG8_STAGE(PG8_SA(0, 0), a2, voffA);
            PG8_WAIT_V(8); PG8_WAIT_L(0); PG8_BAR; PG8_MMA(1, 0, At, B0); PG8_MMA(1, 1, At, B1); PG8_BAR; PG8_SCHED;
            PG8_LDB(B0, 1, 0); PG8_LDB(B1, 1, 1); PG8_SCHED; PG8_LDA(At, 1, 0); PG8_STAGE(PG8_SA(0, 1), a2 + hstep, voffA);
            PG8_WAIT_V(8); PG8_WAIT_L(0); PG8_BAR; PG8_MMA(0, 0, At, B0); PG8_MMA(0, 1, At, B1); PG8_BAR; PG8_SCHED;
            PG8_LDA(At, 1, 1); PG8_STAGE(PG8_SB(1, 0), b3, voffB); PG8_STAGE(PG8_SB(1, 1), b3 + hstep, voffB); PG8_STAGE(PG8_SA(1, 0), a3, voffA);
            PG8_WAIT_V(8); PG8_WAIT_L(0); PG8_BAR; PG8_MMA(1, 0, At, B0); PG8_MMA(1, 1, At, B1); PG8_BAR; PG8_SCHED;
            } else {
            PG8_LDB(B0, 0, 0); PG8_SCHED; PG8_LDA(At, 0, 0); PG8_STAGE(PG8_SA(1, 1), a1 + hstep, voffA);
            PG8_WAIT_L(8); PG8_BAR; PG8_WAIT_L(0); PG8_MMA(0, 0, At, B0); PG8_BAR; PG8_SCHED;
            PG8_LDB(B1, 0, 1); PG8_STAGE(PG8_SB(0, 0), b2, voffB);
            PG8_BAR; PG8_WAIT_L(0); PG8_MMA(0, 1, At, B1); PG8_BAR;
            PG8_LDA(At, 0, 1); PG8_STAGE(PG8_SA(0, 0), a2, voffA);
            PG8_BAR; PG8_WAIT_L(0); PG8_MMA(1, 0, At, B0); PG8_BAR; PG8_SCHED;
            PG8_STAGE(PG8_SB(0, 1), b2 + hstep, voffB);
            PG8_WAIT_V(6); PG8_BAR; PG8_MMA(1, 1, At, B1); PG8_BAR;
            PG8_LDB(B0, 1, 0); PG8_SCHED; PG8_LDA(At, 1, 0); PG8_STAGE(PG8_SA(0, 1), a2 + hstep, voffA);
            PG8_WAIT_L(8); PG8_BAR; PG8_WAIT_L(0); PG8_MMA(0, 0, At, B0); PG8_BAR; PG8_SCHED;
            PG8_LDB(B1, 1, 1); PG8_STAGE(PG8_SB(1, 0), b3, voffB);
            PG8_BAR; PG8_WAIT_L(0); PG8_MMA(0, 1, At, B1); PG8_BAR;
            PG8_LDA(At, 1, 1); PG8_STAGE(PG8_SA(1, 0), a3, voffA);
            PG8_BAR; PG8_WAIT_L(0); PG8_MMA(1, 0, At, B0); PG8_BAR; PG8_SCHED;
            PG8_STAGE(PG8_SB(1, 1), b3 + hstep, voffB);
            PG8_WAIT_V(6); PG8_BAR; PG8_MMA(1, 1, At, B1); PG8_BAR;
            }
        }
        if constexpr (ALIGN_EPI) { if (wr == 0) PG8_BAR; }
        if constexpr (!Epi::AFTER_DRAIN) { E(acc, cur, wr, wc, fr, fq); S.done(cur); }
        if (!has_next) break;
#pragma unroll
        for (int a = 0; a < 2; ++a)
#pragma unroll
            for (int b = 0; b < 2; ++b)
#pragma unroll
                for (int m = 0; m < 4; ++m)
#pragma unroll
                    for (int n = 0; n < 2; ++n) acc[a][b][m][n] = (f32x4){0.f, 0.f, 0.f, 0.f};
        cur = nxt; cA = nA; cB = nB; ++ui;
        if constexpr (ALIGN_EPI) { if (wr == 1) PG8_BAR; }
    }
    PG8_WAIT_V(0);
    if constexpr (!ALIGN_EPI) { if (wr == 0) PG8_BAR; }
    PG8_BAR;
    if constexpr (Epi::AFTER_DRAIN) { E.fused(acc, cur, wr, wc, fr, fq, lds, wid, lane); S.done(cur); }
#undef PG8_SA
#undef PG8_SB
#undef PG8_STAGE
#undef PG8_LDA
#undef PG8_LDB
#undef PG8_MMA
#undef PG8_WAIT_V
#undef PG8_WAIT_L
#undef PG8_BAR
#undef PG8_SCHED
}
}
#ifndef MK_N_LAUNCHES
#define MK_N_LAUNCHES 1
#endif
constexpr int NWAVES = 8;
constexpr int DM = 1024, BATCH = 16, SEQ = 2048, CTXL = 256, NHEAD = 4, HD = 256, FF = 4096, PT = 8208;
constexpr int NGRP = 2, GBAT = BATCH / NGRP;
constexpr int RL = GBAT * SEQ, RC = GBAT * CTXL, RT = RL + RC;
constexpr float EPS = 1e-6f;
constexpr int NPG = 10;
constexpr int NPHASE = 1 + NGRP * NPG;

constexpr size_t MiB = 1u << 20;
constexpr size_t WS_CTL = 0, CTL_ZERO_BYTES = 1 * MiB;
constexpr size_t WS_MODX = 1 * MiB, WS_MODC = 1 * MiB + 512 * 1024;
constexpr size_t WS_WIN = 2 * MiB, WS_WA = 18 * MiB, WS_WB = 20 * MiB, WS_WOUT = 22 * MiB, WS_W1 = 24 * MiB, WS_W2 = 32 * MiB;
constexpr size_t WS_GATES = 41 * MiB;
constexpr size_t WS_NST = 43 * MiB;
constexpr size_t WS_XN = 44 * MiB;
constexpr size_t WS_Q = 80 * MiB, WS_K = 116 * MiB;
constexpr size_t WS_KT = 152 * MiB, WS_VT = 188 * MiB;
constexpr size_t WS_O = 224 * MiB, WS_U = 256 * MiB, WS_GA = 288 * MiB, WS_GB = 320 * MiB;
constexpr size_t WS_VGT = 352 * MiB;
constexpr size_t WS_CT = 384 * MiB;
constexpr size_t WS_H1 = 80 * MiB;
constexpr size_t WS_END = 448 * MiB;
constexpr int CW_BAR = 4096;

constexpr int LDS_BYTES = 163840;
constexpr int LDSCTL_OFF = LDS_BYTES - 512, MISC_OFF = LDSCTL_OFF + 320;

#define LAS __attribute__((address_space(3)))
typedef unsigned short bf16;
typedef unsigned v4u __attribute__((ext_vector_type(4)));
typedef unsigned v2u __attribute__((ext_vector_type(2)));
typedef float f32x4 __attribute__((ext_vector_type(4)));
#define LDS_WAIT() asm volatile("s_waitcnt lgkmcnt(0)" ::: "memory")
#define VM_WAIT() asm volatile("s_waitcnt vmcnt(0)" ::: "memory")
__device__ __forceinline__ unsigned f2bf(float f) { unsigned u = __builtin_bit_cast(unsigned, f); return (u + 0x7fffu + ((u >> 16) & 1u)) >> 16; }
__device__ __forceinline__ unsigned pk2(float lo, float hi) { return f2bf(lo) | (f2bf(hi) << 16); }
__device__ __forceinline__ float bflo(unsigned w) { return __builtin_bit_cast(float, w << 16); }
__device__ __forceinline__ float bfhi(unsigned w) { return __builtin_bit_cast(float, w & 0xffff0000u); }
__device__ __forceinline__ float bf2f(bf16 b) { return __builtin_bit_cast(float, ((unsigned)b) << 16); }
__device__ __forceinline__ float wave_sum(float v) {
#pragma unroll
    for (int o = 1; o < 64; o <<= 1) v += __shfl_xor(v, o);
    return v;
}
__device__ __forceinline__ float fexp(float x) { return __builtin_amdgcn_exp2f(x * 1.4426950408889634f); }
__device__ __forceinline__ float sigmoidf_(float x) { return __builtin_amdgcn_rcpf(1.f + fexp(-x)); }
__device__ __forceinline__ float siluf_(float x) { return x * __builtin_amdgcn_rcpf(1.f + fexp(-x)); }
__device__ __forceinline__ float gelu_tanh(float x) {
    const float z2 = 1.5957691216057308f * (x + 0.044715f * x * x * x);
    return x * __builtin_amdgcn_rcpf(1.f + fexp(-z2));
}
__device__ __forceinline__ float logsigmoidf_(float x) { return fminf(x, 0.f) - log1pf(expf(-fabsf(x))); }

typedef short bf16x8 __attribute__((ext_vector_type(8)));
typedef float f32x16 __attribute__((ext_vector_type(16)));
typedef __bf16 bf16x2_t __attribute__((ext_vector_type(2)));
typedef float f32x2_t __attribute__((ext_vector_type(2)));
__device__ __forceinline__ unsigned cvtpk(float lo, float hi) { f32x2_t v = {lo, hi}; bf16x2_t b = __builtin_convertvector(v, bf16x2_t); return __builtin_bit_cast(unsigned, b); }
__device__ __forceinline__ f32x16 mfma32(v4u a, v4u b, f32x16 c) { return __builtin_amdgcn_mfma_f32_32x32x16_bf16(__builtin_bit_cast(bf16x8, a), __builtin_bit_cast(bf16x8, b), c, 0, 0, 0); }
__device__ __forceinline__ void unpack8(v4u w, float (&f)[8]) { f[0] = bflo(w.x); f[1] = bfhi(w.x); f[2] = bflo(w.y); f[3] = bfhi(w.y); f[4] = bflo(w.z); f[5] = bfhi(w.z); f[6] = bflo(w.w); f[7] = bfhi(w.w); }
__device__ __forceinline__ v4u pack8(const float (&f)[8]) { v4u w; w.x = cvtpk(f[0], f[1]); w.y = cvtpk(f[2], f[3]); w.z = cvtpk(f[4], f[5]); w.w = cvtpk(f[6], f[7]); return w; }

#define XB_TMO      128
#define XB_XCNT(j)  (256  + 64 * (j))
#define XB_XSUB(j)  (1280 + 64 * (j))
#define XB_XGEN(j)  (2304 + 64 * (j))
#define XB_TOP      3328
#define XB_TOPGEN   3392
#define XCD_BAR_WORDS 3456
#define XB_SPIN_CAP (1u << 18)

__device__ __forceinline__ unsigned xb_ld(unsigned* p)              { return __hip_atomic_load(p, __ATOMIC_RELAXED, __HIP_MEMORY_SCOPE_AGENT); }
__device__ __forceinline__ unsigned xb_add(unsigned* p, unsigned v) { return __hip_atomic_fetch_add(p, v, __ATOMIC_RELAXED, __HIP_MEMORY_SCOPE_AGENT); }
__device__ __forceinline__ unsigned xb_xcc_id() { return (unsigned)__builtin_amdgcn_s_getreg((3 << 11) | 20) & 0xFu; }
#define XB_SPIN(cond, bar) do { unsigned _sp = 0; while (cond) { __builtin_amdgcn_s_sleep(1); \
    if ((++_sp & 255u) == 0u) { if (xb_ld(&(bar)[XB_TMO])) break; if (_sp > XB_SPIN_CAP) { atomicAdd(&(bar)[XB_TMO], 1u); break; } } } } while (0)

struct XcdBarrier {
    unsigned* bar; unsigned x;
    volatile LAS unsigned* st;
};

__device__ __forceinline__ XcdBarrier xcd_barrier_post(unsigned* bar, volatile LAS unsigned* st) {
    XcdBarrier b; b.bar = bar; b.x = xb_xcc_id(); b.st = st;
    if (threadIdx.x == 0) (void)xb_add(&bar[XB_XCNT(b.x)], 1u);
    return b;
}
__device__ __forceinline__ void xcd_barrier_complete(unsigned* bar, unsigned x, unsigned& nloc, unsigned& nx) {
    const unsigned G = gridDim.x * gridDim.y * gridDim.z;
    unsigned sum, cnt, mine, sp = 0u;
    for (;;) {
        sum = 0u; cnt = 0u; mine = 0u;
#pragma unroll
        for (unsigned j = 0; j < 16; ++j) { const unsigned c = xb_ld(&bar[XB_XCNT(j)]); sum += c; cnt += (c > 0u) ? 1u : 0u; mine = (j == x) ? c : mine; }
        if (sum == G) break;
        __builtin_amdgcn_s_sleep(1);
        if ((++sp & 255u) == 0u) { if (xb_ld(&bar[XB_TMO])) break; if (sp > XB_SPIN_CAP) { atomicAdd(&bar[XB_TMO], 1u); break; } }
    }
    nloc = mine > 0u ? mine : 1u; nx = cnt > 0u ? cnt : 1u;
}

__device__ __forceinline__ void xcd_barrier(const XcdBarrier& b) {
    asm volatile("s_waitcnt vmcnt(0)" ::: "memory");
    __syncthreads();
    if (threadIdx.x == 0) {
        unsigned* bar = b.bar;
        __builtin_amdgcn_s_waitcnt(0);
        unsigned nloc = b.st[0], nx = b.st[1];
        if (nloc == 0u) { xcd_barrier_complete(bar, b.x, nloc, nx); b.st[0] = nloc; b.st[1] = nx; }
        const unsigned old = xb_add(&bar[XB_XSUB(b.x)], 1u);
        const unsigned gen = old / nloc;
        if (old + 1u == (gen + 1u) * nloc) {
            __builtin_amdgcn_fence(__ATOMIC_RELEASE, "agent");
            asm volatile("s_waitcnt vmcnt(0)" ::: "memory");
            const unsigned og = xb_add(&bar[XB_TOP], 1u);
            const unsigned tg = og / nx;
            if (og + 1u == (tg + 1u) * nx) xb_add(&bar[XB_TOPGEN], 1u);
            else XB_SPIN(xb_ld(&bar[XB_TOPGEN]) == tg, bar);
            __builtin_amdgcn_fence(__ATOMIC_ACQUIRE, "agent");
            xb_add(&bar[XB_XGEN(b.x)], 1u);
            asm volatile("s_waitcnt vmcnt(0)" ::: "memory");
        } else {
            XB_SPIN(xb_ld(&bar[XB_XGEN(b.x)]) == gen, bar);
            __builtin_amdgcn_fence(__ATOMIC_ACQUIRE, "agent");
            asm volatile("s_waitcnt vmcnt(0)" ::: "memory");
        }
    }
    __syncthreads();
}
struct Args { const float* in[21]; float* out; unsigned char* ws; int ph_lo, ph_hi; };
enum { I_X = 0, I_C, I_CTX, I_CCTX, I_NORM1, I_NORM2, I_WMOD, I_BMOD, I_WIN, I_CONV, I_BGATE, I_GMH, I_WA, I_WS, I_BS, I_GSGU, I_WB, I_WOUT, I_W1, I_W2, I_NORMF };

struct Gemm1Order {
    pg8::StaticOrder so; int G, c;
    __device__ void init(int G_, int c_) { G = G_; c = c_; so.init(RL, 24 * 256, G_, c_); }
    __device__ bool next(int i, pg8::Unit& u) const {
        const int L = i * G + c;
        if (L < 1536) { so.next(i, u); const int pn = u.pn; u.pn = pn + (pn >= 8 ? 4 : 0) + (pn >= 16 ? 4 : 0); u.kind = 0; return true; }
        if (L < 1600) { const int r = L - 1536; u.pm = 64 + (r >> 3); u.pn = r & 7; u.kind = 0; return true; }
        if (L < 2368) { const int r = L - 1600, tt = r / 12, wi = r % 12; u.pm = wi < 4 ? 4 + wi : (wi < 8 ? 4 + wi : 12 + wi); u.pn = tt; u.kind = 1; return true; }
        if (L < 2432) { const int r = L - 2368; u.pm = 4 + (r & 7); u.pn = 64 + (r >> 3); u.kind = 1; return true; }
        return false;
    }
    __device__ __forceinline__ void a_ready(const pg8::Unit&) const {}
    __device__ __forceinline__ void done(const pg8::Unit&) const {}
    __device__ __forceinline__ const char* pa(const pg8::Gemm& g, const pg8::Unit& u, size_t tstep) const { return (const char*)(u.kind ? g.Bt : g.A) + (size_t)u.pm * tstep; }
    __device__ __forceinline__ const char* pb(const pg8::Gemm& g, const pg8::Unit& u, size_t tstep) const { return (const char*)(u.kind ? g.A : g.Bt) + (size_t)u.pn * tstep; }
};

struct EpiPx {
    static constexpr bool PERM = true, AFTER_DRAIN = false;
    unsigned char* ws;
    __device__ __forceinline__ void operator()(const pg8::f32x4 (&acc)[2][2][4][2], const pg8::Unit& u, int wr, int wc, int fr, int fq) const {
        asm volatile("" : "+v"(fr), "+v"(fq));
        const int wt = u.kind ? u.pm : u.pn, gidx = wt >> 2;
        size_t boff; int pitch; bool act;
        if (u.kind == 0) { boff = gidx == 0 ? WS_Q : gidx == 1 ? WS_K : gidx == 3 ? WS_O : gidx == 4 ? WS_U : gidx == 6 ? WS_GA : WS_GB; pitch = DM; act = (gidx == 4); }
        else { boff = gidx == 1 ? WS_KT : gidx == 2 ? WS_VT : WS_VGT; pitch = gidx == 5 ? RL : RT; act = (gidx == 5); }
        bf16* base = (bf16*)(ws + boff);
        const int rt = u.kind ? (u.pm & 3) : u.pm, ct = u.kind ? u.pn : (u.pn & 3);
        const int row0 = rt * 256 + wr * 64 + fr, col0 = ct * 256 + wc * 32 + 8 * fq;
#pragma unroll
        for (int ai = 0; ai < 2; ++ai)
#pragma unroll
            for (int m = 0; m < 4; ++m) { bf16* rowp = base + (size_t)(row0 + ai * 128 + m * 16) * pitch + col0;
#pragma unroll
                for (int bj = 0; bj < 2; ++bj) { pg8::f32x4 v0 = acc[ai][bj][m][0], v1 = acc[ai][bj][m][1];
                    if (act) {
#pragma unroll
                        for (int j = 0; j < 4; ++j) { v0[j] = gelu_tanh(v0[j]); v1[j] = gelu_tanh(v1[j]); } }
                    v4u w; w.x = pg8::cvt_pk_bf16(v0[0], v0[1]); w.y = pg8::cvt_pk_bf16(v0[2], v0[3]); w.z = pg8::cvt_pk_bf16(v1[0], v1[1]); w.w = pg8::cvt_pk_bf16(v1[2], v1[3]);
                    *(v4u*)(rowp + bj * 128) = w; }
                asm volatile("" ::: "memory"); }
    }
};
template <int MODE> struct EpiGate {
    static constexpr bool PERM = true, AFTER_DRAIN = false;
    const bf16* Gt; bf16* T;
    __device__ __forceinline__ void operator()(const pg8::f32x4 (&acc)[2][2][4][2], const pg8::Unit& u, int wr, int wc, int fr, int fq) const {
        asm volatile("" : "+v"(fr), "+v"(fq));
        const int row0 = u.pm * 256 + wr * 64 + fr, col0 = u.pn * 256 + wc * 32 + 8 * fq;
#pragma unroll
        for (int ai = 0; ai < 2; ++ai)
#pragma unroll
            for (int m = 0; m < 4; ++m) { const size_t off = (size_t)(row0 + ai * 128 + m * 16) * DM + col0;
#pragma unroll
                for (int bj = 0; bj < 2; ++bj) {
                    const v4u gw = *(const v4u*)(Gt + off + bj * 128);
                    float gv[8] = {bflo(gw.x), bfhi(gw.x), bflo(gw.y), bfhi(gw.y), bflo(gw.z), bfhi(gw.z), bflo(gw.w), bfhi(gw.w)};
                    float tv[8] = {0.f, 0.f, 0.f, 0.f, 0.f, 0.f, 0.f, 0.f};
                    if (MODE == 1) { const v4u tw = *(const v4u*)(T + off + bj * 128);
                        tv[0] = bflo(tw.x); tv[1] = bfhi(tw.x); tv[2] = bflo(tw.y); tv[3] = bfhi(tw.y); tv[4] = bflo(tw.z); tv[5] = bfhi(tw.z); tv[6] = bflo(tw.w); tv[7] = bfhi(tw.w); }
                    float r[8];
#pragma unroll
                    for (int j = 0; j < 4; ++j) { r[j] = tv[j] + sigmoidf_(gv[j]) * acc[ai][bj][m][0][j]; r[4 + j] = tv[4 + j] + sigmoidf_(gv[4 + j]) * acc[ai][bj][m][1][j]; }
                    v4u w; w.x = pg8::cvt_pk_bf16(r[0], r[1]); w.y = pg8::cvt_pk_bf16(r[2], r[3]); w.z = pg8::cvt_pk_bf16(r[4], r[5]); w.w = pg8::cvt_pk_bf16(r[6], r[7]);
                    *(v4u*)(T + off + bj * 128) = w; }
                asm volatile("" ::: "memory"); }
    }
};
struct EpiRes {
    static constexpr bool PERM = false, AFTER_DRAIN = false;
    const float* resid; float* out; const float* modx; int goff; int grow0;
    __device__ __forceinline__ void operator()(const pg8::f32x4 (&acc)[2][2][4][2], const pg8::Unit& u, int wr, int wc, int fr, int fq) const {
        asm volatile("" : "+v"(fr), "+v"(fq));
        const int growt = grow0 + u.pm * 256, b = growt >> 11;
        const int row0 = growt + wr * 64 + fr, col0 = u.pn * 256 + wc * 32 + 4 * fq;
        const float* gp = modx + (size_t)b * 6144 + goff + col0;
        pg8::f32x4 gv[2][2];
#pragma unroll
        for (int bj = 0; bj < 2; ++bj)
#pragma unroll
            for (int n = 0; n < 2; ++n) gv[bj][n] = *(const pg8::f32x4*)(gp + bj * 128 + n * 16);
#pragma unroll
        for (int ai = 0; ai < 2; ++ai)
#pragma unroll
            for (int m = 0; m < 4; ++m) { const size_t off = (size_t)(row0 + ai * 128 + m * 16) * DM + col0;
#pragma unroll
                for (int bj = 0; bj < 2; ++bj)
#pragma unroll
                    for (int n = 0; n < 2; ++n) { const pg8::f32x4 rv = *(const pg8::f32x4*)(resid + off + bj * 128 + n * 16);
                        *(pg8::f32x4*)(out + off + bj * 128 + n * 16) = rv + gv[bj][n] * acc[ai][bj][m][n]; }
                asm volatile("" ::: "memory"); }
    }
};
struct EpiRelu2 {
    static constexpr bool PERM = true, AFTER_DRAIN = false;
    bf16* O;
    __device__ __forceinline__ void operator()(const pg8::f32x4 (&acc)[2][2][4][2], const pg8::Unit& u, int wr, int wc, int fr, int fq) const {
        asm volatile("" : "+v"(fr), "+v"(fq));
        const int row0 = u.pm * 256 + wr * 64 + fr, col0 = u.pn * 256 + wc * 32 + 8 * fq;
#pragma unroll
        for (int ai = 0; ai < 2; ++ai)
#pragma unroll
            for (int m = 0; m < 4; ++m) { bf16* rowp = O + (size_t)(row0 + ai * 128 + m * 16) * FF + col0;
#pragma unroll
                for (int bj = 0; bj < 2; ++bj) { pg8::f32x4 v0 = acc[ai][bj][m][0], v1 = acc[ai][bj][m][1];
#pragma unroll
                    for (int j = 0; j < 4; ++j) { const float a0 = fmaxf(v0[j], 0.f), a1 = fmaxf(v1[j], 0.f); v0[j] = a0 * a0; v1[j] = a1 * a1; }
                    v4u w; w.x = pg8::cvt_pk_bf16(v0[0], v0[1]); w.y = pg8::cvt_pk_bf16(v0[2], v0[3]); w.z = pg8::cvt_pk_bf16(v1[0], v1[1]); w.w = pg8::cvt_pk_bf16(v1[2], v1[3]);
                    *(v4u*)(rowp + bj * 128) = w; }
                asm volatile("" ::: "memory"); }
    }
};

__device__ __forceinline__ void transpose_item(const float* W, int K, int Npitch, int nblk, bf16* WT, LAS float* scr, int item, int lane, bool win) {
    const int kb = item / nblk, nb = item % nblk, k0 = 64 * kb, n0 = 32 * nb;
    const int ns = win ? (n0 < 3072 ? n0 : n0 + 16) : n0;
#pragma unroll 8
    for (int i = 0; i < 32; ++i) { const int kk = 2 * i + (lane >> 5); scr[kk * 33 + (lane & 31)] = W[(size_t)(k0 + kk) * Npitch + ns + (lane & 31)]; }
    LDS_WAIT(); asm volatile("" ::: "memory");
    const int c = lane & 7;
#pragma unroll
    for (int j = 0; j < 4; ++j) { const int n = (lane >> 3) + 8 * j; const LAS float* s = scr + (8 * c) * 33 + n;
        v4u o; o.x = pk2(s[0 * 33], s[1 * 33]); o.y = pk2(s[2 * 33], s[3 * 33]); o.z = pk2(s[4 * 33], s[5 * 33]); o.w = pk2(s[6 * 33], s[7 * 33]);
        *(v4u*)(WT + (size_t)(n0 + n) * K + k0 + 8 * c) = o; }
    LDS_WAIT(); asm volatile("" ::: "memory");
}

__device__ __forceinline__ void phase_p0(const Args& a, LAS unsigned char* lds, int tid, int lane, int wave, int vcu, int G) {
    float* modx = (float*)(a.ws + WS_MODX); float* modc = (float*)(a.ws + WS_MODC);
    if (blockIdx.x < 96) {
        const float* c = a.in[I_C]; const float* cctx = a.in[I_CCTX]; const float* wmod = a.in[I_WMOD]; const float* bmod = a.in[I_BMOD];
        LAS float* sc = (LAS float*)lds;
        for (int i = tid; i < 17 * 1024; i += 512) { const float v = i < 16 * 1024 ? c[i] : cctx[i - 16 * 1024]; sc[i] = v / (1.f + expf(-v)); }
        __syncthreads();
        const int n = blockIdx.x * 64 + lane;
        float acc[17];
#pragma unroll
        for (int b = 0; b < 17; ++b) acc[b] = 0.f;
        const int k0 = wave * 128;
        for (int kk = 0; kk < 128; ++kk) { const int k = k0 + kk; const float w = wmod[(size_t)k * 6144 + n];
#pragma unroll
            for (int b = 0; b < 17; ++b) acc[b] += sc[b * 1024 + k] * w; }
        LAS float* red = (LAS float*)(lds + 69632);
#pragma unroll
        for (int b = 0; b < 17; ++b) red[(wave * 17 + b) * 64 + lane] = acc[b];
        __syncthreads();
        for (int i = tid; i < 17 * 64; i += 512) { const int b = i >> 6, l = i & 63; float s = 0.f;
#pragma unroll
            for (int w = 0; w < 8; ++w) s += red[(w * 17 + b) * 64 + l];
            const int nn = blockIdx.x * 64 + l; s += bmod[nn];
            if (b < 16) modx[(size_t)b * 6144 + nn] = s; else if (nn < 2048) modc[nn] = s; }
        __syncthreads();
    }
    LAS float* scr = (LAS float*)(lds + wave * 8448);
    const int gw = vcu * NWAVES + wave, NGW = G * NWAVES;
    constexpr int I_IN = 16 * 256, I_SQ = 16 * 32, I_1 = 16 * 128, I_2 = 64 * 32;
    constexpr int NITEMS = I_IN + 3 * I_SQ + I_1 + I_2;
    for (int it = gw; it < NITEMS; it += NGW) {
        int r = it;
        if (r < I_IN) { transpose_item(a.in[I_WIN], DM, PT, 256, (bf16*)(a.ws + WS_WIN), scr, r, lane, true); continue; } r -= I_IN;
        if (r < I_SQ) { transpose_item(a.in[I_WA], DM, DM, 32, (bf16*)(a.ws + WS_WA), scr, r, lane, false); continue; } r -= I_SQ;
        if (r < I_SQ) { transpose_item(a.in[I_WB], DM, DM, 32, (bf16*)(a.ws + WS_WB), scr, r, lane, false); continue; } r -= I_SQ;
        if (r < I_SQ) { transpose_item(a.in[I_WOUT], DM, DM, 32, (bf16*)(a.ws + WS_WOUT), scr, r, lane, false); continue; } r -= I_SQ;
        if (r < I_1) { transpose_item(a.in[I_W1], DM, FF, 128, (bf16*)(a.ws + WS_W1), scr, r, lane, false); continue; } r -= I_1;
        transpose_item(a.in[I_W2], FF, DM, 32, (bf16*)(a.ws + WS_W2), scr, r, lane, false);
    }
}

__device__ __forceinline__ void phase_b1(const Args& a, LAS unsigned char* lds, int g, int tid, int lane, int wave, int vcu, int G) {
    LAS float* wgT = (LAS float*)lds;
    { const float* win = a.in[I_WIN];
      for (int i = tid; i < 16384; i += 512) { const int k = i >> 4, gi = i & 15; wgT[gi * 1024 + k] = win[(size_t)k * PT + 3072 + gi]; } }
    __syncthreads();
    const float* modx = (const float*)(a.ws + WS_MODX); const float* modc = (const float*)(a.ws + WS_MODC);
    const float* norm1 = a.in[I_NORM1]; const float* bgate = a.in[I_BGATE];
    bf16* XN = (bf16*)(a.ws + WS_XN); float* GATES = (float*)(a.ws + WS_GATES);
    const int gw = vcu * NWAVES + wave, NGW = G * NWAVES;
    for (int row = gw; row < RT; row += NGW) {
        const float* src; const float* sh; const float* sc;
        if (row < RL) { const int b = g * GBAT + (row >> 11), t = row & 2047; src = a.in[I_X] + ((size_t)b * SEQ + t) * DM; sh = modx + (size_t)b * 6144; sc = sh + 1024; }
        else { const int rr = row - RL, b = g * GBAT + (rr >> 8), t = rr & 255; src = a.in[I_CTX] + ((size_t)b * CTXL + t) * DM; sh = modc; sc = modc + 1024; }
        f32x4 v[4]; float ss = 0.f;
#pragma unroll
        for (int j = 0; j < 4; ++j) { v[j] = *(const f32x4*)(src + 4 * lane + 256 * j); ss += (v[j].x * v[j].x + v[j].y * v[j].y) + (v[j].z * v[j].z + v[j].w * v[j].w); }
        const float rstd = rsqrtf(wave_sum(ss) * (1.f / DM) + EPS);
#pragma unroll
        for (int j = 0; j < 4; ++j) { const f32x4 n1 = *(const f32x4*)(norm1 + 4 * lane + 256 * j), s1 = *(const f32x4*)(sc + 4 * lane + 256 * j), h1 = *(const f32x4*)(sh + 4 * lane + 256 * j);
            v[j] = v[j] * rstd * n1 * (s1 + 1.f) + h1;
            v2u o; o.x = pk2(v[j].x, v[j].y); o.y = pk2(v[j].z, v[j].w);
            *(v2u*)(XN + (size_t)row * DM + 4 * lane + 256 * j) = o; }
        float mine = 0.f;
#pragma unroll 1
        for (int gi = 0; gi < 16; ++gi) { float p = 0.f;
#pragma unroll
            for (int j = 0; j < 4; ++j) { const f32x4 w4 = *(const LAS f32x4*)(wgT + gi * 1024 + 256 * j + 4 * lane); p += (v[j].x * w4.x + v[j].y * w4.y) + (v[j].z * w4.z + v[j].w * w4.w); }
            p = wave_sum(p); if (lane == gi) mine = p; }
        if (lane < 16) { float val = mine + bgate[lane]; if ((lane >> 2) & 1) val = logsigmoidf_(val); GATES[(size_t)row * 16 + lane] = val; }
    }
}


__device__ __forceinline__ void scan256(const float (&x)[4], float (&p)[4], float& tot, int lane) {
    p[0] = x[0]; p[1] = p[0] + x[1]; p[2] = p[1] + x[2]; p[3] = p[2] + x[3];
    float s = p[3];
#pragma unroll
    for (int o = 1; o < 64; o <<= 1) { const float y = __shfl_up(s, o); if (lane >= o) s += y; }
    const float excl = s - p[3];
    p[0] += excl; p[1] += excl; p[2] += excl; p[3] += excl;
    tot = __shfl(s, 63);
}

__device__ __forceinline__ void phase_scan(const Args& a, LAS unsigned char* lds, int g, int tid, int lane, int wave, int bx, int G) {
    const bf16* KT = (const bf16*)(a.ws + WS_KT); const bf16* VT = (const bf16*)(a.ws + WS_VT);
    const float* GATES = (const float*)(a.ws + WS_GATES); bf16* CT = (bf16*)(a.ws + WS_CT); float* NST = (float*)(a.ws + WS_NST);
    const float* conv = a.in[I_CONV];
    LAS float* eL = (LAS float*)lds;
    const int r = lane & 31, hh = lane >> 5;
    for (int item = bx; item < GBAT * NHEAD * 2 * 4; item += G) {
        const int bl = item >> 5, h = (item >> 3) & 3, dir = (item >> 2) & 1, vs = item & 3;
        const int chk = h * HD + wave * 32 + r;
        const float w0 = conv[1024 + chk], w1 = conv[2048 + 1024 + chk], w2 = conv[4096 + 1024 + chk];
        const bf16* kbase = KT + (size_t)chk * RT;
        const bf16* vbase0 = VT + (size_t)(h * HD + vs * 64 + r) * RT; const bf16* vbase1 = vbase0 + (size_t)32 * RT;
        f32x16 acc0, acc1;
#pragma unroll
        for (int i = 0; i < 16; ++i) { acc0[i] = 0.f; acc1[i] = 0.f; }
        float nacc = 0.f;
        for (int step = 0; step < 9; ++step) {
            const int c = step == 0 ? -1 : (dir ? 8 - step : step - 1);
            const int tok0 = c < 0 ? RL + bl * CTXL : bl * SEQ + c * 256;
            __syncthreads();
            if (wave == 0) {
                float lf[4], li[4], pr[4], tot;
#pragma unroll
                for (int j = 0; j < 4; ++j) { const float* gp = GATES + (size_t)(tok0 + 4 * lane + j) * 16 + dir * 8 + h; li[j] = gp[0]; lf[j] = gp[4]; }
                scan256(lf, pr, tot, lane);
#pragma unroll
                for (int j = 0; j < 4; ++j) eL[4 * lane + j] = dir ? __expf(pr[j] - lf[j] + li[j]) : __expf(tot - pr[j] + li[j]);
                if (lane == 0) eL[256] = __expf(tot);
            }
            __syncthreads();
            if (c >= 0) {
                const size_t sidx = (size_t)(((bl * NHEAD + h) * 2 + dir) * 8 + c);
                bf16* cp = CT + sidx * 65536 + (size_t)(vs * 64 + r) * 256 + wave * 32 + 4 * hh;
#pragma unroll
                for (int q = 0; q < 4; ++q) { v2u o0, o1; o0.x = cvtpk(acc0[4 * q], acc0[4 * q + 1]); o0.y = cvtpk(acc0[4 * q + 2], acc0[4 * q + 3]); o1.x = cvtpk(acc1[4 * q], acc1[4 * q + 1]); o1.y = cvtpk(acc1[4 * q + 2], acc1[4 * q + 3]);
                    *(v2u*)(cp + 8 * q) = o0; *(v2u*)(cp + 32 * 256 + 8 * q) = o1; }
                const float nf = nacc + __shfl_xor(nacc, 32);
                if (vs == 0 && hh == 0) NST[sidx * 256 + wave * 32 + r] = nf;
            }
            if (step == 8) break;
            const float decay = eL[256];
#pragma unroll
            for (int i = 0; i < 16; ++i) { acc0[i] *= decay; acc1[i] *= decay; }
            nacc *= decay;
            const bool has_l = c > 0, has_r = c >= 0 && c < 7;
            for (int s = 0; s < 16; ++s) {
                const int t = 16 * s + 8 * hh;
                const bf16* kp = kbase + tok0 + t;
                const v4u kw = *(const v4u*)kp;
                const float xl = (t > 0 || has_l) ? bf2f(kp[-1]) : 0.f, xr = (t + 8 < 256 || has_r) ? bf2f(kp[8]) : 0.f;
                float x[8]; unpack8(kw, x);
                const f32x4 e0 = *(const LAS f32x4*)(eL + t), e1 = *(const LAS f32x4*)(eL + t + 4);
                const float ev[8] = {e0.x, e0.y, e0.z, e0.w, e1.x, e1.y, e1.z, e1.w};
                float y[8];
#pragma unroll
                for (int j = 0; j < 8; ++j) { const float xm = j == 0 ? xl : x[j - 1], xp = j == 7 ? xr : x[j + 1];
                    y[j] = siluf_(w0 * xm + w1 * x[j] + w2 * xp) * 0.0625f * ev[j]; nacc += y[j]; }
                const v4u af = pack8(y);
                const v4u b0 = *(const v4u*)(vbase0 + tok0 + t), b1 = *(const v4u*)(vbase1 + tok0 + t);
                acc0 = mfma32(af, b0, acc0); acc1 = mfma32(af, b1, acc1);
            }
        }
    }
}

__device__ __forceinline__ void phase_sgate(const Args& a, LAS unsigned char* lds, int g, int tid, int lane, int wave, int bx, int G) {
    const bf16* VGT = (const bf16*)(a.ws + WS_VGT); bf16* U = (bf16*)(a.ws + WS_U);
    const float* wsp = a.in[I_WS]; const float* bsp = a.in[I_BS]; const float* gsgu = a.in[I_GSGU];
    LAS float* red = (LAS float*)(lds + 2048);
    LAS float* rs = (LAS float*)(lds + 2048 + 16384);
    const int r = lane & 31, hh = lane >> 5;
    for (int task = bx; task < GBAT * 16; task += G) {
        const int bl = task >> 4, n = task & 15, r0 = bl * SEQ + n * 128;
        __syncthreads();
        { float ss[8];
#pragma unroll
          for (int e = 0; e < 8; ++e) ss[e] = 0.f;
          const int chunk = tid & 15, chr = tid >> 4;
          for (int ps = 0; ps < 32; ++ps) { const v4u w = *(const v4u*)(VGT + (size_t)(ps * 32 + chr) * RL + r0 + chunk * 8); float f[8]; unpack8(w, f);
#pragma unroll
              for (int e = 0; e < 8; ++e) ss[e] += f[e] * f[e]; }
#pragma unroll
          for (int e = 0; e < 8; ++e) red[chr * 128 + chunk * 8 + e] = ss[e]; }
        __syncthreads();
        if (tid < 128) { float s = 0.f; for (int i = 0; i < 32; ++i) s += red[i * 128 + tid]; rs[tid] = rsqrtf(s * (1.f / DM) + EPS); }
        __syncthreads();
        const int c0 = (wave & 3) * 32, ph = wave >> 2;
        for (int gg = 0; gg < 8; ++gg) {
            f32x16 acc[2];
#pragma unroll
            for (int i = 0; i < 16; ++i) { acc[0][i] = 0.f; acc[1][i] = 0.f; }
            const bf16* ap = VGT + (size_t)(gg * 128 + c0 + r) * RL + r0 + 8 * hh;
#pragma unroll 2
            for (int s = 0; s < 8; ++s) {
                const v4u af = *(const v4u*)(ap + 16 * s);
                const int q0 = 16 * s + 8 * hh;
                const f32x4 ra = *(const LAS f32x4*)(rs + q0), rb = *(const LAS f32x4*)(rs + q0 + 4);
#pragma unroll
                for (int pt = 0; pt < 2; ++pt) { const float* wp = wsp + ((size_t)gg * 128 + ph * 64 + pt * 32 + r) * 128 + q0;
                    const f32x4 wa = *(const f32x4*)wp, wb = *(const f32x4*)(wp + 4);
                    v4u bf; bf.x = cvtpk(wa.x * ra.x, wa.y * ra.y); bf.y = cvtpk(wa.z * ra.z, wa.w * ra.w); bf.z = cvtpk(wb.x * rb.x, wb.y * rb.y); bf.w = cvtpk(wb.z * rb.z, wb.w * rb.w);
                    acc[pt] = mfma32(af, bf, acc[pt]); }
            }
#pragma unroll
            for (int pt = 0; pt < 2; ++pt) { const int p = ph * 64 + pt * 32 + r; const float bsv = bsp[gg * 128 + p];
                bf16* up = U + (size_t)(r0 + p) * DM + gg * 128 + c0 + 4 * hh;
#pragma unroll
                for (int q = 0; q < 4; ++q) { const f32x4 gs = *(const f32x4*)(gsgu + gg * 128 + c0 + 8 * q + 4 * hh);
                    const v2u uw = *(const v2u*)(up + 8 * q);
                    v2u o; o.x = cvtpk(bflo(uw.x) * (acc[pt][4 * q] * gs.x + bsv), bfhi(uw.x) * (acc[pt][4 * q + 1] * gs.y + bsv));
                    o.y = cvtpk(bflo(uw.y) * (acc[pt][4 * q + 2] * gs.z + bsv), bfhi(uw.y) * (acc[pt][4 * q + 3] * gs.w + bsv));
                    *(v2u*)(up + 8 * q) = o; } }
        }
    }
}

constexpr int OQ_PITCH = 528, OA_PITCH = 272;
constexpr int O_QL = 0, O_R2 = 67584, O_AB = O_R2 + 34816, O_GT = O_R2 + 69632  , O_MISC = O_GT + 4096  ;
template <int UNR> __device__ __forceinline__ void stage_conv_rows(const bf16* src, const float* cw, LAS unsigned char* dst, int row_first  , int tseq_first, float scl, int tid) {
#pragma unroll UNR
    for (int i = 0; i < 8; ++i) { const int cid = tid + 512 * i, row = cid >> 5, cc = cid & 31;
        const bf16* sp = src + (size_t)(row_first + row) * DM + cc * 8; const int tseq = tseq_first + row;
        const v4u z = {0u, 0u, 0u, 0u};
        const v4u r1 = *(const v4u*)sp; const v4u r0 = tseq > 0 ? *(const v4u*)(sp - DM) : z; const v4u r2 = tseq < SEQ - 1 ? *(const v4u*)(sp + DM) : z;
        float x0[8], x1[8], x2[8], y[8]; unpack8(r0, x0); unpack8(r1, x1); unpack8(r2, x2);
        const f32x4 wa0 = *(const f32x4*)(cw + cc * 8), wb0 = *(const f32x4*)(cw + cc * 8 + 4), wa1 = *(const f32x4*)(cw + 2048 + cc * 8), wb1 = *(const f32x4*)(cw + 2048 + cc * 8 + 4), wa2 = *(const f32x4*)(cw + 4096 + cc * 8), wb2 = *(const f32x4*)(cw + 4096 + cc * 8 + 4);
        const float w0[8] = {wa0.x, wa0.y, wa0.z, wa0.w, wb0.x, wb0.y, wb0.z, wb0.w}, w1[8] = {wa1.x, wa1.y, wa1.z, wa1.w, wb1.x, wb1.y, wb1.z, wb1.w}, w2[8] = {wa2.x, wa2.y, wa2.z, wa2.w, wb2.x, wb2.y, wb2.z, wb2.w};
#pragma unroll
        for (int e = 0; e < 8; ++e) y[e] = siluf_(w0[e] * x0[e] + w1[e] * x1[e] + w2[e] * x2[e]) * scl;
        *(LAS v4u*)(dst + row * OQ_PITCH + cc * 16) = pack8(y); }
}
__device__ __forceinline__ void phase_mout(const Args& a, LAS unsigned char* lds, int g, int tid, int lane, int wave, int bx, int G) {
    const bf16* Q = (const bf16*)(a.ws + WS_Q); const bf16* K = (const bf16*)(a.ws + WS_K); const bf16* VT = (const bf16*)(a.ws + WS_VT);
    const float* GATES = (const float*)(a.ws + WS_GATES); const bf16* CT = (const bf16*)(a.ws + WS_CT); const float* NST = (const float*)(a.ws + WS_NST);
    bf16* O = (bf16*)(a.ws + WS_O); const float* conv = a.in[I_CONV]; const float* gmh = a.in[I_GMH];
    LAS unsigned char* QL = lds + O_QL; LAS unsigned char* KL = lds + O_R2; LAS unsigned char* AF = lds + O_R2; LAS unsigned char* AB = lds + O_AB;
    LAS float* pf = (LAS float*)(lds + O_GT); LAS float* lif = pf + 256; LAS float* qb = pf + 512; LAS float* lib = pf + 768;
    LAS float* gF = (LAS float*)(lds + O_MISC); LAS float* gB = gF + 128; LAS float* dqF = gF + 256; LAS float* dqB = gF + 384;
    LAS float* denP = gF + 512;
    LAS float* rF = gF + 1536; LAS float* rB = gF + 1664; LAS float* ssq = gF + 1792;
    LAS float* totb = gF + 2816;
#define FRESH_IDS() int lane_f = lane; asm volatile("" : "+v"(lane_f)); const int r = lane_f & 31, hh = lane_f >> 5
    for (int item = bx; item < GBAT * NHEAD * 8 * 2; item += G) {
        const int bl = item >> 6, h = (item >> 4) & 3, c = (item >> 1) & 7, half = item & 1;
        const int cb = bl * SEQ + c * 256, i0 = cb + half * 128;
        __syncthreads();
        if (wave < 2) { float lf[4], li[4], pr[4], tot;
#pragma unroll
            for (int j = 0; j < 4; ++j) { const float* gp = GATES + (size_t)(cb + 4 * lane + j) * 16 + wave * 8 + h; li[j] = gp[0]; lf[j] = gp[4]; }
            scan256(lf, pr, tot, lane);
            if (wave == 0) {
#pragma unroll
                for (int j = 0; j < 4; ++j) { pf[4 * lane + j] = pr[j]; lif[4 * lane + j] = li[j]; } }
            else {
#pragma unroll
                for (int j = 0; j < 4; ++j) { qb[4 * lane + j] = pr[j] - lf[j]; lib[4 * lane + j] = li[j]; }
                if (lane == 0) totb[0] = tot; } }
        stage_conv_rows<4>(Q + h * HD, conv + h * HD, QL, i0, c * 256 + half * 128, 1.f, tid);
        __syncthreads();
        const size_t sF = (size_t)(((bl * NHEAD + h) * 2 + 0) * 8 + c), sB = sF + 8;
        if (tid < 256) { const int row = tid & 127, d = tid >> 7; const int ig = half * 128 + row;
            if (d == 0) gF[row] = __expf(pf[ig]); else gB[row] = __expf(totb[0] - qb[ig]);
            const float* np = NST + (d ? sB : sF) * 256; float s = 0.f;
            for (int k8 = 0; k8 < 32; ++k8) { const v4u qw = *(const LAS v4u*)(QL + row * OQ_PITCH + k8 * 16); float qf[8]; unpack8(qw, qf);
                const f32x4 na = *(const f32x4*)(np + k8 * 8), nb = *(const f32x4*)(np + k8 * 8 + 4);
                s += (qf[0] * na.x + qf[1] * na.y) + (qf[2] * na.z + qf[3] * na.w) + (qf[4] * nb.x + qf[5] * nb.y) + (qf[6] * nb.z + qf[7] * nb.w); }
            (d ? dqB : dqF)[row] = s; }
        __syncthreads();
        f32x16 accF[4], accB[4];
#pragma unroll
        for (int it = 0; it < 4; ++it)
#pragma unroll
            for (int i = 0; i < 16; ++i) { accF[it][i] = 0.f; accB[it][i] = 0.f; }
        { FRESH_IDS(); float gf4[4], gb4[4];
#pragma unroll
          for (int it = 0; it < 4; ++it) { gf4[it] = gF[32 * it + r]; gb4[it] = gB[32 * it + r]; }
          const bf16* cfp = CT + sF * 65536 + (size_t)(wave * 32 + r) * 256 + 8 * hh; const bf16* cbp = CT + sB * 65536 + (size_t)(wave * 32 + r) * 256 + 8 * hh;
#pragma unroll 2
          for (int s = 0; s < 16; ++s) { const v4u aF = *(const v4u*)(cfp + 16 * s), aB = *(const v4u*)(cbp + 16 * s);
#pragma unroll
              for (int it = 0; it < 4; ++it) { const v4u qw = *(const LAS v4u*)(QL + (32 * it + r) * OQ_PITCH + (16 * s + 8 * hh) * 2); float qf[8], t1[8], t2[8]; unpack8(qw, qf);
#pragma unroll
                  for (int e = 0; e < 8; ++e) { t1[e] = qf[e] * gf4[it]; t2[e] = qf[e] * gb4[it]; }
                  accF[it] = mfma32(aF, pack8(t1), accF[it]); accB[it] = mfma32(aB, pack8(t2), accB[it]); } } }
        for (int kb = 0; kb < 2; ++kb) {
            __syncthreads();
            stage_conv_rows<2>(K + h * HD, conv + 1024 + h * HD, KL, cb + kb * 128, c * 256 + kb * 128, 0.0625f, tid);
            __syncthreads();
            const int it = wave & 3, jh = wave >> 2;
            f32x16 st0, st1;
            { FRESH_IDS();
#pragma unroll
            for (int i = 0; i < 16; ++i) { st0[i] = 0.f; st1[i] = 0.f; }
#pragma unroll 4
            for (int s = 0; s < 16; ++s) { const int ko = (16 * s + 8 * hh) * 2;
                const v4u qw = *(const LAS v4u*)(QL + (32 * it + r) * OQ_PITCH + ko);
                const v4u k0 = *(const LAS v4u*)(KL + (jh * 64 + r) * OQ_PITCH + ko), k1 = *(const LAS v4u*)(KL + (jh * 64 + 32 + r) * OQ_PITCH + ko);
                st0 = mfma32(k0, qw, st0); st1 = mfma32(k1, qw, st1); } }
            __syncthreads();
            const bool needF = kb <= half, needB = kb >= half;
            { FRESH_IDS(); const int i = 32 * it + r, ig = half * 128 + i; const float pfi = pf[ig], qbi = qb[ig];
              float rsF = 0.f, rsB = 0.f;
#pragma unroll
              for (int jt = 0; jt < 2; ++jt)
#pragma unroll
                  for (int q = 0; q < 4; ++q) { const int j = jh * 64 + jt * 32 + 8 * q + 4 * hh, jg = kb * 128 + j;
                      const f32x4 pfj = *(const LAS f32x4*)(pf + jg), lfj = *(const LAS f32x4*)(lif + jg), qbj = *(const LAS f32x4*)(qb + jg), lbj = *(const LAS f32x4*)(lib + jg);
                      float af[4], ab[4];
#pragma unroll
                      for (int e = 0; e < 4; ++e) { const float sv = jt ? st1[4 * q + e] : st0[4 * q + e];
                          af[e] = (needF && jg + e <= ig) ? sv * __expf(pfi - pfj[e] + lfj[e]) : 0.f;
                          ab[e] = (needB && jg + e >= ig) ? sv * __expf(qbj[e] - qbi + lbj[e]) : 0.f;
                          rsF += af[e]; rsB += ab[e]; }
                      v2u wF, wB; wF.x = cvtpk(af[0], af[1]); wF.y = cvtpk(af[2], af[3]); wB.x = cvtpk(ab[0], ab[1]); wB.y = cvtpk(ab[2], ab[3]);
                      *(LAS v2u*)(AF + i * OA_PITCH + j * 2) = wF; *(LAS v2u*)(AB + i * OA_PITCH + j * 2) = wB; }
              rsF += __shfl_xor(rsF, 32); rsB += __shfl_xor(rsB, 32);
              if (hh == 0) { denP[((0 * 2 + kb) * 2 + jh) * 128 + i] = rsF; denP[((1 * 2 + kb) * 2 + jh) * 128 + i] = rsB; } }
            __syncthreads();
            { FRESH_IDS(); const bf16* vp = VT + (size_t)(h * HD + wave * 32 + r) * RT + cb + kb * 128 + 8 * hh;
#pragma unroll 2
              for (int s = 0; s < 8; ++s) { const v4u av = *(const v4u*)(vp + 16 * s); const int ko = (16 * s + 8 * hh) * 2;
#pragma unroll
                  for (int t4 = 0; t4 < 4; ++t4) {
                      if (needF) { const v4u bw = *(const LAS v4u*)(AF + (32 * t4 + r) * OA_PITCH + ko); accF[t4] = mfma32(av, bw, accF[t4]); }
                      if (needB) { const v4u bw = *(const LAS v4u*)(AB + (32 * t4 + r) * OA_PITCH + ko); accB[t4] = mfma32(av, bw, accB[t4]); } } } }
        }
        __syncthreads();
        if (tid < 128) { const float dF = ((denP[0 * 128 + tid] + denP[1 * 128 + tid]) + (denP[2 * 128 + tid] + denP[3 * 128 + tid])) + gF[tid] * dqF[tid];
            const float dB = ((denP[4 * 128 + tid] + denP[5 * 128 + tid]) + (denP[6 * 128 + tid] + denP[7 * 128 + tid])) + gB[tid] * dqB[tid];
            rF[tid] = 1.f / fmaxf(fabsf(dF), 1.f); rB[tid] = 1.f / fmaxf(fabsf(dB), 1.f); }
        __syncthreads();
        { FRESH_IDS();
#pragma unroll
        for (int t4 = 0; t4 < 4; ++t4) { const int i = 32 * t4 + r; const float rf = rF[i], rb = rB[i];
            const bf16* op = O + (size_t)(i0 + i) * DM + h * HD + wave * 32 + 4 * hh; float sq = 0.f;
#pragma unroll
            for (int q = 0; q < 4; ++q) { const v2u ow = *(const v2u*)(op + 8 * q); const float og[4] = {bflo(ow.x), bfhi(ow.x), bflo(ow.y), bfhi(ow.y)};
#pragma unroll
                for (int e = 0; e < 4; ++e) { const float z = sigmoidf_(og[e]) * (rf * accF[t4][4 * q + e] + rb * accB[t4][4 * q + e]); accF[t4][4 * q + e] = z; sq += z * z; } }
            sq += __shfl_xor(sq, 32);
            if (hh == 0) ssq[wave * 128 + i] = sq; } }
        __syncthreads();
        { FRESH_IDS();
#pragma unroll
        for (int t4 = 0; t4 < 4; ++t4) { const int i = 32 * t4 + r; float s = 0.f;
#pragma unroll
            for (int w = 0; w < 8; ++w) s += ssq[w * 128 + i];
            const float rstd = rsqrtf(s * (1.f / HD) + EPS);
            bf16* op = O + (size_t)(i0 + i) * DM + h * HD + wave * 32 + 4 * hh;
#pragma unroll
            for (int q = 0; q < 4; ++q) { const f32x4 gm = *(const f32x4*)(gmh + h * HD + wave * 32 + 8 * q + 4 * hh);
                v2u o; o.x = cvtpk(accF[t4][4 * q] * rstd * gm.x, accF[t4][4 * q + 1] * rstd * gm.y); o.y = cvtpk(accF[t4][4 * q + 2] * rstd * gm.z, accF[t4][4 * q + 3] * rstd * gm.w);
                *(v2u*)(op + 8 * q) = o; } } }
    }
#undef FRESH_IDS
}

__device__ __forceinline__ void phase_b8(const Args& a, int g, int lane, int wave, int vcu, int G) {
    const float* X1 = a.out + (size_t)g * RL * DM; bf16* XN = (bf16*)(a.ws + WS_XN);
    const float* modx = (const float*)(a.ws + WS_MODX); const float* norm2 = a.in[I_NORM2];
    const int gw = vcu * NWAVES + wave, NGW = G * NWAVES;
    for (int row = gw; row < RL; row += NGW) {
        const int b = g * GBAT + (row >> 11);
        const float* sh = modx + (size_t)b * 6144 + 3 * 1024; const float* sc = sh + 1024;
        f32x4 v[4]; float ss = 0.f;
#pragma unroll
        for (int j = 0; j < 4; ++j) { v[j] = *(const f32x4*)(X1 + (size_t)row * DM + 4 * lane + 256 * j); ss += (v[j].x * v[j].x + v[j].y * v[j].y) + (v[j].z * v[j].z + v[j].w * v[j].w); }
        const float rstd = rsqrtf(wave_sum(ss) * (1.f / DM) + EPS);
#pragma unroll
        for (int j = 0; j < 4; ++j) { const f32x4 n2 = *(const f32x4*)(norm2 + 4 * lane + 256 * j), s2 = *(const f32x4*)(sc + 4 * lane + 256 * j), h2 = *(const f32x4*)(sh + 4 * lane + 256 * j);
            const f32x4 y = v[j] * rstd * n2 * (s2 + 1.f) + h2;
            v2u o; o.x = pk2(y.x, y.y); o.y = pk2(y.z, y.w);
            *(v2u*)(XN + (size_t)row * DM + 4 * lane + 256 * j) = o; }
    }
}
__device__ __forceinline__ void phase_b11(const Args& a, int g, int lane, int wave, int vcu, int G) {
    float* X2 = a.out + (size_t)g * RL * DM; const float* normf = a.in[I_NORMF];
    const int gw = vcu * NWAVES + wave, NGW = G * NWAVES;
    for (int row = gw; row < RL; row += NGW) {
        f32x4 v[4]; float ss = 0.f;
#pragma unroll
        for (int j = 0; j < 4; ++j) { v[j] = *(const f32x4*)(X2 + (size_t)row * DM + 4 * lane + 256 * j); ss += (v[j].x * v[j].x + v[j].y * v[j].y) + (v[j].z * v[j].z + v[j].w * v[j].w); }
        const float rstd = rsqrtf(wave_sum(ss) * (1.f / DM) + EPS);
#pragma unroll
        for (int j = 0; j < 4; ++j) { const f32x4 nf = *(const f32x4*)(normf + 4 * lane + 256 * j);
            *(f32x4*)(X2 + (size_t)row * DM + 4 * lane + 256 * j) = v[j] * rstd * nf; }
    }
}

#define PHASE_IDS() int tid_p = tid, wave_p = wave, vcu_p = vcu, bx_p = bx; asm volatile("" : "+v"(tid_p), "+s"(wave_p), "+s"(vcu_p), "+s"(bx_p)); const int lane_p = tid_p & 63; (void)lane_p
__global__ void __launch_bounds__(NWAVES * 64, 2) fwd(Args a) {
    extern __shared__ __attribute__((aligned(16))) unsigned char lds_raw[];
    LAS unsigned char* lds = (LAS unsigned char*)lds_raw;
    const int tid = threadIdx.x, lane = tid & 63, wave = __builtin_amdgcn_readfirstlane(tid >> 6);
    const int G = gridDim.x; const int bx = blockIdx.x; const int vcu = (G % 8 == 0) ? (bx % 8) * (G / 8) + bx / 8 : bx;
    volatile LAS unsigned* MISC = (volatile LAS unsigned*)(lds + MISC_OFF);
    for (int u = tid; u < (LDS_BYTES - LDSCTL_OFF) / 4; u += NWAVES * 64) ((LAS unsigned*)(lds + LDSCTL_OFF))[u] = 0u;
    __syncthreads();
    XcdBarrier bar; bar.bar = (unsigned*)(a.ws + WS_CTL) + CW_BAR; bar.x = 0; bar.st = nullptr;
    if (a.ph_hi - a.ph_lo > 1) bar = xcd_barrier_post((unsigned*)(a.ws + WS_CTL) + CW_BAR, MISC + 8);
    const int lo = a.ph_lo, hi = a.ph_hi;
#ifndef PHASE_MASK
#define PHASE_MASK 0xFFF
#endif
#define ON(k) ((PHASE_MASK >> (k)) & 1)
#define IN(k) (lo <= (k) && (k) < hi)
#define SEAM(k) do { if (IN(k) && IN((k) + 1)) xcd_barrier(bar); } while (0)
    typedef pg8::bf16_t pb;
    if (ON(11) && IN(0)) { PHASE_IDS(); phase_p0(a, lds, tid_p, lane_p, wave_p, vcu_p, G); SEAM(0); }
    for (int g = 0; g < NGRP; ++g) {
        const int pb0 = 1 + g * NPG;
        if (ON(0) && IN(pb0 + 0)) { PHASE_IDS(); phase_b1(a, lds, g, tid_p, lane_p, wave_p, vcu_p, G); SEAM(pb0 + 0); }
        if (ON(1) && IN(pb0 + 1)) { PHASE_IDS();
            pg8::Gemm gm{(const pb*)(a.ws + WS_XN), (const pb*)(a.ws + WS_WIN), RT, 8192, DM}; Gemm1Order S; S.init(G, bx_p); EpiPx E{a.ws};
            pg8::gemm_phase<EpiPx, Gemm1Order, true, true>(lds, gm, S, E);
            SEAM(pb0 + 1); }
        if (ON(2) && IN(pb0 + 2)) { { PHASE_IDS(); phase_scan(a, lds, g, tid_p, lane_p, wave_p, bx_p, G); }
            { PHASE_IDS(); phase_sgate(a, lds, g, tid_p, lane_p, wave_p, bx_p, G); }
            SEAM(pb0 + 2); }
        if (ON(3) && IN(pb0 + 3)) { PHASE_IDS(); phase_mout(a, lds, g, tid_p, lane_p, wave_p, bx_p, G); SEAM(pb0 + 3); }
        if (ON(4) && IN(pb0 + 4)) { PHASE_IDS();
            { pg8::Gemm gm{(const pb*)(a.ws + WS_O), (const pb*)(a.ws + WS_WA), RL, DM, DM}; pg8::StaticOrder S; S.init(RL, DM, G, bx_p);
              EpiGate<0> E{(const bf16*)(a.ws + WS_GA), (bf16*)(a.ws + WS_GA)};
              pg8::gemm_phase<EpiGate<0>, pg8::StaticOrder, false, true>(lds, gm, S, E); }
            { pg8::Gemm gm{(const pb*)(a.ws + WS_U), (const pb*)(a.ws + WS_WB), RL, DM, DM}; pg8::StaticOrder S; S.init(RL, DM, G, bx_p);
              EpiGate<1> E{(const bf16*)(a.ws + WS_GB), (bf16*)(a.ws + WS_GA)};
              pg8::gemm_phase<EpiGate<1>, pg8::StaticOrder, false, true>(lds, gm, S, E); }
            SEAM(pb0 + 4); }
        if (ON(5) && IN(pb0 + 5)) { PHASE_IDS();
            pg8::Gemm gm{(const pb*)(a.ws + WS_GA), (const pb*)(a.ws + WS_WOUT), RL, DM, DM}; pg8::StaticOrder S; S.init(RL, DM, G, bx_p);
            EpiRes E{a.in[I_X], a.out, (const float*)(a.ws + WS_MODX), 2 * 1024, g * RL};
            pg8::gemm_phase<EpiRes, pg8::StaticOrder, false, true>(lds, gm, S, E);
            SEAM(pb0 + 5); }
        if (ON(6) && IN(pb0 + 6)) { PHASE_IDS(); phase_b8(a, g, lane_p, wave_p, vcu_p, G); SEAM(pb0 + 6); }
        if (ON(7) && IN(pb0 + 7)) { PHASE_IDS();
            pg8::Gemm gm{(const pb*)(a.ws + WS_XN), (const pb*)(a.ws + WS_W1), RL, FF, DM}; pg8::StaticOrder S; S.init(RL, FF, G, bx_p);
            EpiRelu2 E{(bf16*)(a.ws + WS_H1)};
            pg8::gemm_phase<EpiRelu2, pg8::StaticOrder, true, true>(lds, gm, S, E);
            SEAM(pb0 + 7); }
        if (ON(8) && IN(pb0 + 8)) { PHASE_IDS();
            pg8::Gemm gm{(const pb*)(a.ws + WS_H1), (const pb*)(a.ws + WS_W2), RL, DM, FF}; pg8::StaticOrder S; S.init(RL, DM, G, bx_p);
            EpiRes E{a.out, a.out, (const float*)(a.ws + WS_MODX), 5 * 1024, g * RL};
            pg8::gemm_phase<EpiRes, pg8::StaticOrder, false, true>(lds, gm, S, E);
            SEAM(pb0 + 8); }
        if (ON(9) && IN(pb0 + 9)) { PHASE_IDS(); phase_b11(a, g, lane_p, wave_p, vcu_p, G); SEAM(pb0 + 9); }
    }
#undef IN
#undef SEAM
}

extern "C" void kernel_launch(void* const* d_in, const int* in_sizes, int n_in, void* d_out, int out_size, void* d_ws, size_t ws_size, hipStream_t stream) {
    static int grid = 0;
    if (grid == 0) {
        if (n_in != 21 || out_size != BATCH * SEQ * DM || ws_size < WS_END) { fprintf(stderr, "kernel_launch: unexpected shapes (n_in %d, out %d, ws %zu < %zu)\n", n_in, out_size, ws_size, (size_t)WS_END); grid = -1; return; }
        int dev = 0, cus = 0, per_cu = 0;
        if (hipGetDevice(&dev) != hipSuccess || hipDeviceGetAttribute(&cus, hipDeviceAttributeMultiprocessorCount, dev) != hipSuccess) { grid = -1; return; }
        if (hipFuncSetAttribute((const void*)fwd, hipFuncAttributeMaxDynamicSharedMemorySize, LDS_BYTES) != hipSuccess) { fprintf(stderr, "kernel_launch: hipFuncSetAttribute failed\n"); grid = -1; return; }
        if (hipOccupancyMaxActiveBlocksPerMultiprocessor(&per_cu, (const void*)fwd, NWAVES * 64, LDS_BYTES) != hipSuccess || per_cu < 1) { fprintf(stderr, "kernel_launch: occupancy query says %d\n", per_cu); per_cu = 1; }
        (void)hipGetLastError();
        grid = cus * (per_cu < 1 ? per_cu : 1);
    }
    if (grid < 0) return;
    (void)hipMemsetAsync((char*)d_ws + WS_CTL, 0, CTL_ZERO_BYTES, stream);
    Args a{};
    for (int i = 0; i < 21; ++i) a.in[i] = (const float*)d_in[i];
    a.out = (float*)d_out; a.ws = (unsigned char*)d_ws;
#if MK_N_LAUNCHES == 1
    a.ph_lo = 0; a.ph_hi = NPHASE;
    { void* kargs[] = {(void*)&a};
      hipError_t e = hipLaunchCooperativeKernel((const void*)fwd, dim3(grid), dim3(NWAVES * 64), kargs, LDS_BYTES, stream);
      if (e != hipSuccess) fprintf(stderr, "kernel_launch: cooperative launch failed: %s (grid %d)\n", hipGetErrorString(e), grid); }
#else
    for (int p = 0; p < NPHASE; ++p) { a.ph_lo = p; a.ph_hi = p + 1; hipLaunchKernelGGL(fwd, dim3(grid), dim3(NWAVES * 64), LDS_BYTES, stream, a); }
#endif
}
```
